# Optimizing an MI355X kernel written in HIP

```python
import jax, jax.numpy as jnp
from jax import lax
import numpy as np

D_MODEL = 1024
BATCH = 8
SEQ = 4096
DEPTH = 4

GRID_W = 64
RMS_EPS = 1e-6
LB_FLOOR = 1e-12
MASK_VALUE = -1e30
A_DK = 128
A_DV = A_DK
A_WIDTH = D_MODEL // 2
A_HEADS = A_WIDTH // A_DK
HGRN_CHUNK = 32
B_DH = 64
B_WIDTH = D_MODEL - A_WIDTH
B_HEADS = B_WIDTH // B_DH
NA_KR = 8
NA_KC = 16
C_CONFIGS = ((128, 1), (512, 4), (2048, 16))
C_GROUPS = len(C_CONFIGS)
C_DH = 64
C_WIDTH = D_MODEL // 2
C_HPG = C_WIDTH // C_DH
ATTN_BLOCK = 128
POOL_WINDOWS = (2, 4, 8, 16)
POOL_CH = D_MODEL - C_WIDTH
POOL_GC = POOL_CH // len(POOL_WINDOWS)
D_FF = ((8 * D_MODEL // 3 + 255) // 256) * 256
FFN_CONV = 3
EVEN_IN = 5 * A_WIDTH + 3 * B_WIDTH
ODD_IN = 3 * C_GROUPS * C_WIDTH + POOL_CH
MIX_W = D_MODEL
N_EVEN = (DEPTH + 1) // 2
N_ODD = DEPTH // 2

kernel_name = 'hybrid_hgrn2_natten_dilated_pool_encoder'

F32 = jnp.float32


def _rmsnorm(x, g):
    xf = x.astype(F32)
    y = xf * lax.rsqrt(jnp.mean(xf * xf, axis=-1, keepdims=True) + RMS_EPS)
    return (y * g.astype(F32)).astype(x.dtype)


def _alibi_slopes(n):
    return jnp.exp2(-8.0 * jnp.arange(1, n + 1, dtype=F32) / n)


def _gla_scan(q, k, v, log_f):
    B, H, T, DK = q.shape
    DV = v.shape[-1]
    n = T // HGRN_CHUNK

    def chunks(a):
        return jnp.moveaxis(a.reshape(B, H, n, HGRN_CHUNK, a.shape[-1]), 2, 0)

    tril = jnp.tril(jnp.ones((HGRN_CHUNK, HGRN_CHUNK), dtype=bool))[:, :, None]

    def step(S, inp):
        qc, kc, vc, lfc = inp
        b = jnp.cumsum(lfc, axis=2)
        b_last = b[:, :, -1:, :]
        diff = b[:, :, :, None, :] - b[:, :, None, :, :]
        decay = jnp.where(tril, jnp.exp(jnp.where(tril, diff, 0.0)), 0.0)
        att = jnp.einsum('bhck,bhsk,bhcsk->bhcs', qc, kc, decay)
        o = jnp.einsum('bhcs,bhsv->bhcv', att, vc) + jnp.einsum('bhck,bhkv->bhcv', qc * jnp.exp(b), S)
        S = jnp.exp(b_last[:, :, 0, :, None]) * S + jnp.einsum('bhsk,bhsv->bhkv', kc * jnp.exp(b_last - b), vc)
        return S, o

    S0 = jnp.zeros((B, H, DK, DV), F32)
    _, o = lax.scan(step, S0, (chunks(q), chunks(k), chunks(v), chunks(log_f)))
    return jnp.moveaxis(o, 0, 2).reshape(B, H, T, DV)


def _hgrn2(z, lb, norm_g):
    B, T, _ = z.shape
    q, f_fwd, f_bwd, i, g = jnp.split(z.astype(F32), 5, axis=-1)

    def heads(a):
        return a.reshape(B, T, A_HEADS, -1).transpose(0, 2, 1, 3)

    q = heads(jax.nn.silu(q))
    v = heads(i)
    lb = lb.astype(F32).reshape(A_HEADS, 1, A_DK)
    log_lb = jnp.log(jnp.maximum(lb, LB_FLOOR))
    log_1m_lb = jnp.log1p(-lb)

    def gates(fz):
        fz = heads(fz)
        log_f = jnp.logaddexp(log_lb, log_1m_lb + jax.nn.log_sigmoid(fz))
        k = (1.0 - lb) * jax.nn.sigmoid(-fz)
        return k, log_f

    k_f, lf_f = gates(f_fwd)
    k_b, lf_b = gates(f_bwd)
    o_fwd = _gla_scan(q, k_f, v, lf_f)
    flip = lambda a: jnp.flip(a, axis=2)
    o_bwd = flip(_gla_scan(flip(q), flip(k_b), flip(v), flip(lf_b)))
    o = o_fwd + o_bwd
    o = o * lax.rsqrt(jnp.mean(o * o, axis=-1, keepdims=True) + RMS_EPS) * norm_g.astype(F32)
    return o.transpose(0, 2, 1, 3).reshape(B, T, A_WIDTH) * jax.nn.silu(g)


def _neighbourhood_attention(q, k, v, rpb):
    B, T, H, DH = q.shape
    rows = T // GRID_W
    kr = min(NA_KR, rows)
    grid = lambda a: a.astype(F32).reshape(B, rows, GRID_W, H, DH)
    qg, kg, vg = grid(q), grid(k), grid(v)
    col = jnp.arange(GRID_W)
    col_idx = jnp.clip(col - NA_KC // 2, 0, GRID_W - NA_KC)[:, None] + jnp.arange(NA_KC)[None, :]
    rpb_col = rpb.astype(F32)[:, :, col_idx - col[:, None] + NA_KC - 1]
    scale = DH ** -0.5

    def row_block(args):
        r, q_row = args
        rs = jnp.clip(r - kr // 2, 0, rows - kr)
        k_win = lax.dynamic_slice_in_dim(kg, rs, kr, axis=1)[:, :, col_idx]
        v_win = lax.dynamic_slice_in_dim(vg, rs, kr, axis=1)[:, :, col_idx]
        bias = rpb_col[:, rs + jnp.arange(kr) - r + NA_KR - 1]
        s = jnp.einsum('bchd,bicjhd->bhcij', q_row, k_win) * scale + jnp.transpose(bias, (0, 2, 1, 3))[None]
        p = jax.nn.softmax(s.reshape(B, H, GRID_W, kr * NA_KC), axis=-1).reshape(s.shape)
        return jnp.einsum('bhcij,bicjhd->bchd', p, v_win)

    o = lax.map(row_block, (jnp.arange(rows), jnp.moveaxis(qg, 1, 0)))
    return jnp.moveaxis(o, 0, 1).reshape(B, T, H * DH)


def _dilated_attention(q, k, v, slopes):
    B, T = q.shape[:2]
    scale = C_DH ** -0.5

    def block(t0):
        pos = t0 + jnp.arange(ATTN_BLOCK)
        q_blk = lax.dynamic_slice_in_dim(q, t0, ATTN_BLOCK, axis=1).astype(F32)
        outs, lses = [], []
        for g, (window, dil) in enumerate(C_CONFIGS):
            per_side = window // 2 // dil
            offs = dil * jnp.arange(-per_side, per_side + 1)
            idx = pos[:, None] + offs[None, :]
            valid = (idx >= 0) & (idx < T)
            idx = jnp.clip(idx, 0, T - 1)
            k_sel = k[:, idx, g].astype(F32)
            v_sel = v[:, idx, g].astype(F32)
            s = jnp.einsum('bqhd,bqjhd->bhqj', q_blk[:, :, g], k_sel) * scale
            s = s - slopes[g][:, None, None] * jnp.abs(offs).astype(F32)
            s = jnp.where(valid, s, MASK_VALUE)
            m = jnp.max(s, axis=-1, keepdims=True)
            p = jnp.exp(s - m)
            den = jnp.sum(p, axis=-1, keepdims=True)
            outs.append(jnp.einsum('bhqj,bqjhd->bhqd', p / den, v_sel))
            lses.append(m + jnp.log(den))
        w = jax.nn.softmax(jnp.stack(lses), axis=0)
        o = jnp.sum(w * jnp.stack(outs), axis=0)
        return jnp.transpose(o, (0, 2, 1, 3))

    o = lax.map(block, jnp.arange(T // ATTN_BLOCK) * ATTN_BLOCK)
    return jnp.moveaxis(o, 0, 1).reshape(B, T, C_HPG * C_DH)


def _multiscale_pool(u, w_groups, scale):
    B, T, _ = u.shape
    uf = u.astype(F32)
    cs = jnp.concatenate([jnp.zeros((B, 1, POOL_CH), F32), jnp.cumsum(uf, axis=1)], axis=1)
    t = jnp.arange(T)
    outs = []
    for g, w in enumerate(POOL_WINDOWS):
        lo = jnp.clip(t - w // 2, 0, T)
        hi = jnp.clip(t + w - w // 2, 0, T)
        sl = slice(g * POOL_GC, (g + 1) * POOL_GC)
        mean = (cs[:, hi, sl] - cs[:, lo, sl]) / (hi - lo).astype(F32)[None, :, None]
        outs.append(jnp.einsum('btc,cd->btd', mean - uf[:, :, sl], w_groups[g].astype(F32)))
    return (jnp.concatenate(outs, axis=-1) * scale.astype(F32)).astype(u.dtype)


def _conv_ffn(h, w_up, conv_w, conv_b, w_down):
    T = h.shape[1]
    gate, val = jnp.split(h @ w_up, 2, axis=-1)
    gp = jnp.pad(gate, ((0, 0), (FFN_CONV // 2, FFN_CONV // 2), (0, 0)))
    gate = conv_b + sum(gp[:, j:j + T] * conv_w[j] for j in range(FFN_CONV))
    return (jax.nn.silu(gate) * val) @ w_down


def setup_inputs(seed: int = 0) -> dict:
    key = jax.random.key(seed)
    ks = jax.random.split(key, 20)
    nrm = lambda k, shape, s=1.0: s * jax.random.normal(k, shape, F32)
    return {
        'x': nrm(ks[0], (BATCH, SEQ, D_MODEL)),
        'c': nrm(ks[1], (BATCH, D_MODEL)),
        'ada_w': nrm(ks[2], (DEPTH, D_MODEL, 6 * D_MODEL), 0.5 * D_MODEL ** -0.5),
        'ada_b': nrm(ks[3], (DEPTH, 6 * D_MODEL), 0.02),
        'norm_mix_g': 1.0 + nrm(ks[4], (DEPTH, D_MODEL), 0.1),
        'norm_ffn_g': 1.0 + nrm(ks[5], (DEPTH, D_MODEL), 0.1),
        'even_w_in': nrm(ks[6], (N_EVEN, D_MODEL, EVEN_IN), D_MODEL ** -0.5),
        'even_w_out': nrm(ks[7], (N_EVEN, MIX_W, D_MODEL), MIX_W ** -0.5),
        'hgrn_lb_logits': nrm(ks[8], (N_EVEN, A_WIDTH)),
        'hgrn_norm_g': 1.0 + nrm(ks[9], (N_EVEN, A_DV), 0.1),
        'na_rpb': nrm(ks[10], (N_EVEN, B_HEADS, 2 * NA_KR - 1, 2 * NA_KC - 1), 0.1),
        'odd_w_in': nrm(ks[11], (N_ODD, D_MODEL, ODD_IN), D_MODEL ** -0.5),
        'odd_w_out': nrm(ks[12], (N_ODD, MIX_W, D_MODEL), MIX_W ** -0.5),
        'pool_w': nrm(ks[13], (N_ODD, len(POOL_WINDOWS), POOL_GC, POOL_GC), POOL_GC ** -0.5),
        'pool_scale': 1.0 + nrm(ks[14], (N_ODD, POOL_CH), 0.1),
        'ffn_w_up': nrm(ks[15], (DEPTH, D_MODEL, 2 * D_FF), D_MODEL ** -0.5),
        'ffn_conv_w': nrm(ks[16], (DEPTH, FFN_CONV, D_FF), FFN_CONV ** -0.5),
        'ffn_conv_b': nrm(ks[17], (DEPTH, D_FF), 0.02),
        'ffn_w_down': nrm(ks[18], (DEPTH, D_FF, D_MODEL), D_FF ** -0.5),
        'final_norm_g': 1.0 + nrm(ks[19], (D_MODEL,), 0.1),
    }


def reference(x, c, ada_w, ada_b, norm_mix_g, norm_ffn_g, even_w_in, even_w_out, hgrn_lb_logits, hgrn_norm_g, na_rpb, odd_w_in, odd_w_out, pool_w, pool_scale, ffn_w_up, ffn_conv_w, ffn_conv_b, ffn_w_down, final_norm_g):
    B, T, _ = x.shape
    lb_soft = jax.nn.softmax(hgrn_lb_logits.astype(F32), axis=0)
    lower_bounds = jnp.cumsum(lb_soft, axis=0) - lb_soft[0]
    slopes = _alibi_slopes(C_GROUPS * C_HPG).reshape(C_GROUPS, C_HPG)
    c_act = jax.nn.silu(c)
    n_c = 3 * C_GROUPS * C_WIDTH
    for l in range(DEPTH):
        mod = c_act @ ada_w[l] + ada_b[l]
        sh1, sc1, g1, sh2, sc2, g2 = jnp.split(mod[:, None, :], 6, axis=-1)
        h = _rmsnorm(x, norm_mix_g[l]) * (1.0 + sc1) + sh1
        if l % 2 == 0:
            e = l // 2
            z = h @ even_w_in[e]
            o_a = _hgrn2(z[..., :5 * A_WIDTH], lower_bounds[e], hgrn_norm_g[e])
            q_b, k_b, v_b = jnp.split(z[..., 5 * A_WIDTH:], 3, axis=-1)
            shape_b = (B, T, B_HEADS, B_DH)
            o_b = _neighbourhood_attention(q_b.reshape(shape_b), k_b.reshape(shape_b), v_b.reshape(shape_b), na_rpb[e])
            mixed = jnp.concatenate([o_a.astype(h.dtype), o_b.astype(h.dtype)], axis=-1) @ even_w_out[e]
        else:
            o_i = l // 2
            z = h @ odd_w_in[o_i]
            q_c, k_c, v_c = jnp.split(z[..., :n_c], 3, axis=-1)
            shape_c = (B, T, C_GROUPS, C_HPG, C_DH)
            o_c = _dilated_attention(q_c.reshape(shape_c), k_c.reshape(shape_c), v_c.reshape(shape_c), slopes)
            o_d = _multiscale_pool(z[..., n_c:], pool_w[o_i], pool_scale[o_i])
            mixed = jnp.concatenate([o_c.astype(h.dtype), o_d], axis=-1) @ odd_w_out[o_i]
        x = x + g1 * mixed
        h = _rmsnorm(x, norm_ffn_g[l]) * (1.0 + sc2) + sh2
        x = x + g2 * _conv_ffn(h, ffn_w_up[l], ffn_conv_w[l], ffn_conv_b[l], ffn_w_down[l])
    return _rmsnorm(x, final_norm_g)
```

```cpp
#include <hip/hip_runtime.h>
#include <hip/hip_cooperative_groups.h>
#include <cstdio>
#include <cstdint>
namespace cg = cooperative_groups;

#define LAS __attribute__((address_space(3)))
typedef unsigned short bf16_t;
typedef short bf16x8 __attribute__((ext_vector_type(8)));
typedef float f32x4 __attribute__((ext_vector_type(4)));
typedef float f32x2 __attribute__((ext_vector_type(2)));
typedef unsigned u32x4 __attribute__((ext_vector_type(4)));
typedef unsigned u32x2 __attribute__((ext_vector_type(2)));

constexpr int NB = 8, SEQ = 4096, DM = 1024, MTOK = NB * SEQ, DFF = 2816, DEPTH = 4;
constexpr int ZAW = 2560;
constexpr float RMS_EPS = 1e-6f;
constexpr float NEG_BIG = -1e30f;
constexpr float LOG2E = 1.4426950408889634f;

constexpr size_t SZ_MOD = (size_t)DEPTH * NB * 6 * DM * 4;
constexpr size_t OFF_MOD = 0;
constexpr size_t OFF_LB = OFF_MOD + SZ_MOD;
constexpr size_t OFF_PRM = OFF_LB + 4096;
constexpr size_t OFF_BAR = OFF_PRM + 4096;
constexpr size_t OFF_WIN = OFF_BAR + 16384;
constexpr size_t OFF_WOUT = OFF_WIN + (size_t)5120 * 1024 * 2;
constexpr size_t OFF_WUP = OFF_WOUT + (size_t)1024 * 1024 * 2;
constexpr size_t OFF_WDN = OFF_WUP + (size_t)5632 * 1024 * 2;
constexpr size_t SZ_WSET = OFF_WDN + (size_t)1024 * 2816 * 2 - OFF_WIN;
constexpr size_t OFF_HB = OFF_WIN + 3 * SZ_WSET;
constexpr size_t OFF_ZB = OFF_HB + (size_t)MTOK * DM * 2;
constexpr size_t SZ_ZB = (size_t)MTOK * 5632 * 2;
constexpr size_t WS_END = OFF_ZB + SZ_ZB;
constexpr size_t ZE_ZA = 0;
constexpr size_t ZE_QN = ZE_ZA + (size_t)MTOK * ZAW * 2;
constexpr size_t ZE_KN = ZE_QN + (size_t)MTOK * 512 * 2;
constexpr size_t ZE_VN = ZE_KN + (size_t)MTOK * 512 * 2;
constexpr size_t ZE_OF = ZE_VN + (size_t)MTOK * 512 * 2;
constexpr size_t ZE_OB = ZE_OF + (size_t)MTOK * 512 * 2;
static_assert(ZE_OB + (size_t)MTOK * 512 * 2 <= SZ_ZB, "even layout");
constexpr size_t ZO_QC = 0;
constexpr size_t ZO_KC = ZO_QC + (size_t)MTOK * 1536 * 2;
constexpr size_t ZO_VC = ZO_KC + (size_t)MTOK * 1536 * 2;
constexpr size_t ZO_PU = ZO_VC + (size_t)MTOK * 1536 * 2;
static_assert(ZO_PU + (size_t)MTOK * 512 * 2 <= SZ_ZB, "odd layout");

constexpr size_t ZF_U = 0;
constexpr size_t ZF_HG = ZF_U + (size_t)MTOK * DFF * 2;
constexpr size_t ZF_HV = ZF_HG + (size_t)512 * 4 * DFF * 4;
static_assert(ZF_HV + (size_t)512 * 2 * DFF * 4 <= SZ_ZB, "ffn layout");

struct Params {
    const float *x, *c, *ada_w, *ada_b, *nmg, *nfg, *ewin, *ewout, *lblog, *hng, *rpb, *owin, *owout, *poolw, *pools, *wup, *convw, *convb, *wdn, *fng;
    float* out; unsigned char* ws;
};

__device__ __forceinline__ int obid() { int t = blockIdx.x; asm volatile("" : "+s"(t)); return t; }
__device__ __forceinline__ int otid() { int t = threadIdx.x; asm volatile("" : "+v"(t)); return t; }
typedef __bf16 bf16x2_t __attribute__((ext_vector_type(2)));
#define GAS __attribute__((address_space(1)))
template <class T> __device__ __forceinline__ T gld(const void* p) { return *(const GAS T*)p; }
template <class T> __device__ __forceinline__ void gst(void* p, T v) { *(GAS T*)p = v; }
template <class T> __device__ __forceinline__ T gld_nt(const void* p) { return __builtin_nontemporal_load((const GAS T*)p); }
__device__ __forceinline__ float shx(float v, int m) { return __int_as_float(__builtin_amdgcn_ds_bpermute((otid() ^ m) << 2, __float_as_int(v))); }
__device__ __forceinline__ unsigned pk2(float lo, float hi) { f32x2 v = {lo, hi}; bf16x2_t b = __builtin_convertvector(v, bf16x2_t); return __builtin_bit_cast(unsigned, b); }
__device__ __forceinline__ float bf_lo(unsigned u) { return __uint_as_float(u << 16); }
__device__ __forceinline__ float bf_hi(unsigned u) { return __uint_as_float(u & 0xffff0000u); }
__device__ __forceinline__ float sigmoidf_(float v) { return __builtin_amdgcn_rcpf(1.0f + __expf(-v)); }
__device__ __forceinline__ float siluf_(float v) { return v * __builtin_amdgcn_rcpf(1.0f + __expf(-v)); }
__device__ __forceinline__ f32x4 mfma16(bf16x8 a, bf16x8 b, f32x4 c) { return __builtin_amdgcn_mfma_f32_16x16x32_bf16(a, b, c, 0, 0, 0); }
__device__ __forceinline__ bf16x8 mk8(u32x2 lo, u32x2 hi) { u32x4 t; t.x = lo.x; t.y = lo.y; t.z = hi.x; t.w = hi.y; return __builtin_bit_cast(bf16x8, t); }
__device__ __forceinline__ bf16x8 mk8u(unsigned a, unsigned b, unsigned c, unsigned d) { u32x4 t; t.x = a; t.y = b; t.z = c; t.w = d; return __builtin_bit_cast(bf16x8, t); }
__device__ __forceinline__ void unpack8(u32x4 r, float (&v)[8]) { v[0] = bf_lo(r.x); v[1] = bf_hi(r.x); v[2] = bf_lo(r.y); v[3] = bf_hi(r.y); v[4] = bf_lo(r.z); v[5] = bf_hi(r.z); v[6] = bf_lo(r.w); v[7] = bf_hi(r.w); }
__device__ __forceinline__ u32x4 pack8(const float (&v)[8]) { u32x4 o; o.x = pk2(v[0], v[1]); o.y = pk2(v[2], v[3]); o.z = pk2(v[4], v[5]); o.w = pk2(v[6], v[7]); return o; }

namespace pg8 {
constexpr int BM = 256, BK = 64, HALF = 128, HTB = HALF * BK * 2, STAGE_BYTES = 8 * HTB, NXCD = 8, WGM = 8;
__host__ __device__ __forceinline__ int lds_byte(int r, int c) { const int st = (r >> 4) * 2 + (c >> 5), rr = r & 15, cc = c & 31, ob = rr * 64 + cc * 2; return st * 1024 + (ob ^ (((ob >> 9) & 1) << 5)); }
__host__ __device__ __forceinline__ void stage_rc(int b, int& R, int& C) { const int st = b / 1024, sb = b % 1024, swz = sb ^ (((sb >> 9) & 1) << 5); R = (st >> 1) * 16 + swz / 64; C = (st & 1) * 32 + (swz % 64) / 2; }
__host__ __device__ __forceinline__ int perm32(int rho) { const int n = rho >> 4, i = rho & 15; return 8 * (i >> 2) + 4 * n + (i & 3); }

struct Unit { int pm, pn; };
struct Gemm { const bf16_t* A; const bf16_t* Bt; int M, N, K, lda, ldb; };

struct StaticOrder {
    int nM, nN, nwg, G, c;
    __device__ void init(int M, int N, int G_, int c_) { nM = M / BM; nN = N / BM; nwg = nM * nN; G = G_; c = c_; }
    __device__ bool next(int i, Unit& u) const {
        const int L = i * G + c; if (L >= nwg) return false;
        int wgid = L; { const int q = nwg / NXCD, r = nwg % NXCD, xcd = wgid % NXCD, off = wgid / NXCD; wgid = (xcd < r ? xcd * (q + 1) : r * (q + 1) + (xcd - r) * q) + off; }
        const int nig = WGM * nN, gid = wgid / nig, fm = gid * WGM, gsz = (nM - fm) < WGM ? (nM - fm) : WGM;
        u.pm = fm + ((wgid % nig) % gsz); u.pn = (wgid % nig) / gsz; return true;
    }
};

template <class Epi>
__device__ __forceinline__ void gemm_phase(LAS unsigned char* lds, const Gemm g, const StaticOrder& S, const Epi& E) {
    const int tid = otid(), wid = __builtin_amdgcn_readfirstlane(tid >> 6), lane = tid & 63, wr = wid >> 2, wc = wid & 3, fr = lane & 15, fq = lane >> 4;
    const int K = g.K, nt = K / BK;
    unsigned voffA[2], voffB[2];
#pragma unroll
    for (int i = 0; i < 2; ++i) { int R, C; stage_rc(tid * 16 + i * 8192, R, C); const int Rb = Epi::PERM ? ((R & ~31) + perm32(R & 31)) : R;
        voffA[i] = (unsigned)(R * g.lda + C) * 2u; voffB[i] = (unsigned)(Rb * g.ldb + C) * 2u; }
    const size_t kstep = (size_t)(BK * 2);
    const size_t hstepA = (size_t)HALF * g.lda * 2, hstepB = (size_t)HALF * g.ldb * 2;
    const size_t tstepA = 2 * hstepA, tstepB = 2 * hstepB;
    const unsigned ldsw = (unsigned)wid * 1024u;
    const int aoff = lds_byte(wr * 64 + fr, fq * 8), boff = lds_byte(wc * 32 + fr, fq * 8);
#define PG8_SA(b, h) (((b) * 2 + (h)) * HTB)
#define PG8_SB(b, h) ((4 + (b) * 2 + (h)) * HTB)
#define PG8_STAGE(bufoff, gbase, voff) do { _Pragma("unroll") for (int _i = 0; _i < 2; ++_i) \
        __builtin_amdgcn_global_load_lds((const unsigned*)((const char*)(gbase) + (voff)[_i]), (LAS unsigned*)(lds + (bufoff) + ldsw + _i * 8192), 16, 0, 0); } while (0)
#define PG8_LDA(dst, b, h) do { _Pragma("unroll") for (int m = 0; m < 4; ++m) _Pragma("unroll") for (int k = 0; k < 2; ++k) dst[m][k] = *(const LAS bf16x8*)(lds + PG8_SA(b, h) + aoff + m * 2048 + k * 1024); } while (0)
#define PG8_LDB(dst, b, h) do { _Pragma("unroll") for (int n = 0; n < 2; ++n) _Pragma("unroll") for (int k = 0; k < 2; ++k) dst[n][k] = *(const LAS bf16x8*)(lds + PG8_SB(b, h) + boff + n * 2048 + k * 1024); } while (0)
#define PG8_MMA(ai, bj, At, Bt) do { __builtin_amdgcn_s_setprio(1); _Pragma("unroll") for (int m = 0; m < 4; ++m) _Pragma("unroll") for (int n = 0; n < 2; ++n) _Pragma("unroll") for (int k = 0; k < 2; ++k) \
        acc[ai][bj][m][n] = __builtin_amdgcn_mfma_f32_16x16x32_bf16(Bt[n][k], At[m][k], acc[ai][bj][m][n], 0, 0, 0); __builtin_amdgcn_s_setprio(0); } while (0)
#define PG8_WAIT_V(n) asm volatile("s_waitcnt vmcnt(" #n ")" ::: "memory")
#define PG8_WAIT_L(n) asm volatile("s_waitcnt lgkmcnt(" #n ")" ::: "memory")
#define PG8_BAR __builtin_amdgcn_s_barrier()
#define PG8_SCHED __builtin_amdgcn_sched_barrier(0)
    Unit cur, nxt; int ui = 0;
    if (!S.next(0, cur)) return;
    f32x4 acc[2][2][4][2];
#pragma unroll
    for (int a = 0; a < 2; ++a)
#pragma unroll
        for (int b = 0; b < 2; ++b)
#pragma unroll
            for (int m = 0; m < 4; ++m)
#pragma unroll
                for (int n = 0; n < 2; ++n) acc[a][b][m][n] = (f32x4){0.f, 0.f, 0.f, 0.f};
    bf16x8 At[4][2], B0[2][2], B1[2][2];
    const char* cA = (const char*)g.A + (size_t)cur.pm * tstepA; const char* cB = (const char*)g.Bt + (size_t)cur.pn * tstepB;
    PG8_STAGE(PG8_SB(0, 0), cB, voffB); PG8_STAGE(PG8_SA(0, 0), cA, voffA); PG8_STAGE(PG8_SB(0, 1), cB + hstepB, voffB); PG8_STAGE(PG8_SA(0, 1), cA + hstepA, voffA);
    if (wr == 1) PG8_BAR;
    PG8_WAIT_V(4); PG8_BAR;
    PG8_STAGE(PG8_SB(1, 0), cB + kstep, voffB); PG8_STAGE(PG8_SA(1, 0), cA + kstep, voffA); PG8_STAGE(PG8_SB(1, 1), cB + hstepB + kstep, voffB);
    PG8_WAIT_V(6); PG8_BAR;
    for (;;) {
        const bool has_next = S.next(ui + 1, nxt);
        const char* nA = has_next ? (const char*)g.A + (size_t)nxt.pm * tstepA : cA; const char* nB = has_next ? (const char*)g.Bt + (size_t)nxt.pn * tstepB : cB;
        for (int t = 0; t < nt; t += 2) {
            const bool last = (t == nt - 2);
            const char* a1 = cA + (size_t)(t + 1) * kstep;
            const char* a2 = last ? nA : cA + (size_t)(t + 2) * kstep; const char* b2 = last ? nB : cB + (size_t)(t + 2) * kstep;
            const char* a3 = a2 + kstep; const char* b3 = b2 + kstep;
            PG8_LDB(B0, 0, 0); PG8_SCHED; PG8_LDA(At, 0, 0); PG8_STAGE(PG8_SA(1, 1), a1 + hstepA, voffA);
            PG8_WAIT_L(8); PG8_BAR; PG8_WAIT_L(0); PG8_MMA(0, 0, At, B0); PG8_BAR; PG8_SCHED;
            PG8_LDB(B1, 0, 1); PG8_STAGE(PG8_SB(0, 0), b2, voffB);
            PG8_BAR; PG8_WAIT_L(0); PG8_MMA(0, 1, At, B1); PG8_BAR;
            PG8_LDA(At, 0, 1); PG8_STAGE(PG8_SA(0, 0), a2, voffA);
            PG8_BAR; PG8_WAIT_L(0); PG8_MMA(1, 0, At, B0); PG8_BAR; PG8_SCHED;
            PG8_STAGE(PG8_SB(0, 1), b2 + hstepB, voffB);
            PG8_WAIT_V(6); PG8_BAR; PG8_MMA(1, 1, At, B1); PG8_BAR;
            PG8_LDB(B0, 1, 0); PG8_SCHED; PG8_LDA(At, 1, 0); PG8_STAGE(PG8_SA(0, 1), a2 + hstepA, voffA);
            PG8_WAIT_L(8); PG8_BAR; PG8_WAIT_L(0); PG8_MMA(0, 0, At, B0); PG8_BAR; PG8_SCHED;
            PG8_LDB(B1, 1, 1); PG8_STAGE(PG8_SB(1, 0), b3, voffB);
            PG8_BAR; PG8_WAIT_L(0); PG8_MMA(0, 1, At, B1); PG8_BAR;
            PG8_LDA(At, 1, 1); PG8_STAGE(PG8_SA(1, 0), a3, voffA);
            PG8_BAR; PG8_WAIT_L(0); PG8_MMA(1, 0, At, B0); PG8_BAR; PG8_SCHED;
            PG8_STAGE(PG8_SB(1, 1), b3 + hstepB, voffB);
            PG8_WAIT_V(6); PG8_BAR; PG8_MMA(1, 1, At, B1); PG8_BAR;
        }
        E(acc, cur, wr, wc, fr, fq);
        if (!has_next) break;
#pragma unroll
        for (int a = 0; a < 2; ++a)
#pragma unroll
            for (int b = 0; b < 2; ++b)
#pragma unroll
                for (int m = 0; m < 4; ++m)
#pragma unroll
                    for (int n = 0; n < 2; ++n) acc[a][b][m][n] = (f32x4){0.f, 0.f, 0.f, 0.f};
        cur = nxt; cA = nA; cB = nB; ++ui;
    }
    PG8_WAIT_V(0);
    if (wr == 0) PG8_BAR;
    PG8_BAR;
#undef PG8_SA
#undef PG8_SB
#undef PG8_STAGE
#undef PG8_LDA
#undef PG8_LDB
#undef PG8_MMA
#undef PG8_WAIT_V
#undef PG8_WAIT_L
#undef PG8_BAR
#undef PG8_SCHED
}
}
using pg8::Unit;

__device__ __forceinline__ void acc8(const f32x4 (&acc)[2][2][4][2], int ai, int bj, int m, float (&v)[8]) {
    const f32x4 a = acc[ai][bj][m][0], b = acc[ai][bj][m][1];
    v[0] = a[0]; v[1] = a[1]; v[2] = a[2]; v[3] = a[3]; v[4] = b[0]; v[5] = b[1]; v[6] = b[2]; v[7] = b[3];
}

struct EpiEvenIn {
    static constexpr bool PERM = true;
    bf16_t *za, *qn, *kn; const float* lb;
    __device__ __forceinline__ void operator()(const f32x4 (&acc)[2][2][4][2], const Unit& u, int wr, int wc, int fr, int fq) const {
        const int region = u.pn >> 1;
#pragma unroll
        for (int bj = 0; bj < 2; ++bj) {
            const int c8 = u.pn * 256 + bj * 128 + wc * 32 + 8 * fq;
            float lbv[8];
            if (region == 1 || region == 2) {
                const f32x4 l0 = gld<f32x4>(lb + (c8 & 511)), l1 = gld<f32x4>(lb + (c8 & 511) + 4);
                lbv[0] = l0[0]; lbv[1] = l0[1]; lbv[2] = l0[2]; lbv[3] = l0[3]; lbv[4] = l1[0]; lbv[5] = l1[1]; lbv[6] = l1[2]; lbv[7] = l1[3];
            } else {
#pragma unroll
                for (int i = 0; i < 8; ++i) lbv[i] = 0.f;
            }
#pragma unroll
            for (int ai = 0; ai < 2; ++ai)
#pragma unroll
                for (int m = 0; m < 4; ++m) {
                    const int r = u.pm * 256 + ai * 128 + wr * 64 + m * 16 + fr;
                    float v[8]; acc8(acc, ai, bj, m, v);
                    if (region == 0 || region == 4) {
#pragma unroll
                        for (int i = 0; i < 8; ++i) v[i] = siluf_(v[i]);
                    } else if (region == 1 || region == 2) {
#pragma unroll
                        for (int i = 0; i < 8; ++i) { const float f = fmaxf(lbv[i], 1e-12f) + (1.0f - lbv[i]) * sigmoidf_(v[i]); v[i] = __logf(f); }
                    } else if (region == 5) {
#pragma unroll
                        for (int i = 0; i < 8; ++i) v[i] *= 0.125f * LOG2E;
                    }
                    const u32x4 o = pack8(v);
                    if (region < 5) {
                        gst<u32x4>(za + (size_t)r * ZAW + c8, o);
                    } else {
                        const int cc = c8 - (region == 5 ? 2560 : 3072), hh = cc >> 6, dim = cc & 63, b = r >> 12, t = r & 4095;
                        bf16_t* dst = (region == 5 ? qn : kn) + ((size_t)((b * 8 + hh) * 4096 + t)) * 64 + dim;
                        gst<u32x4>(dst, o);
                    }
                }
        }
    }
};
struct EpiEvenV {
    static constexpr bool PERM = true;
    bf16_t* vn;
    __device__ __forceinline__ void operator()(const f32x4 (&acc)[2][2][4][2], const Unit& u, int wr, int wc, int fr, int fq) const {
#pragma unroll
        for (int ai = 0; ai < 2; ++ai)
#pragma unroll
            for (int m = 0; m < 4; ++m) {
                const int r = u.pm * 256 + ai * 128 + wr * 64 + m * 16 + fr;
#pragma unroll
                for (int bj = 0; bj < 2; ++bj) {
                    const int c8 = u.pn * 256 + bj * 128 + wc * 32 + 8 * fq;
                    const int b = c8 >> 12, t = c8 & 4095, hh = r >> 6, dv = r & 63;
                    float v[8]; acc8(acc, ai, bj, m, v);
                    const u32x4 o = pack8(v);
                    bf16_t* dst = vn + ((size_t)(b * 8 + hh) * 1024 + (t >> 2)) * 256 + dv * 4;
                    gst<u32x2>(dst, (u32x2){o.x, o.y}); gst<u32x2>(dst + 256, (u32x2){o.z, o.w});
                }
            }
    }
};
__device__ __forceinline__ int dil_pos(int gi, int t) { const int sh = 2 * gi; return ((t & ((1 << sh) - 1)) << (12 - sh)) | (t >> sh); }
struct EpiOddIn {
    static constexpr bool PERM = true;
    bf16_t *qc, *kc, *pu;
    __device__ __forceinline__ void operator()(const f32x4 (&acc)[2][2][4][2], const Unit& u, int wr, int wc, int fr, int fq) const {
        const int region = u.pn < 6 ? 0 : (u.pn < 12 ? 1 : 2);
#pragma unroll
        for (int ai = 0; ai < 2; ++ai)
#pragma unroll
            for (int m = 0; m < 4; ++m) {
                const int r = u.pm * 256 + ai * 128 + wr * 64 + m * 16 + fr, b = r >> 12, t = r & 4095;
#pragma unroll
                for (int bj = 0; bj < 2; ++bj) {
                    const int c8 = u.pn * 256 + bj * 128 + wc * 32 + 8 * fq;
                    float v[8]; acc8(acc, ai, bj, m, v);
                    if (region == 2) {
                        gst<u32x4>(pu + (size_t)r * 512 + (c8 - 3072), pack8(v));
                    } else {
                        const int cc = c8 - region * 1536, gi = cc >> 9, hh = (cc >> 6) & 7, dim = cc & 63;
                        if (region == 0) {
#pragma unroll
                            for (int i = 0; i < 8; ++i) v[i] *= 0.125f * LOG2E;
                        }
                        bf16_t* dst = (region == 0 ? qc : kc) + ((size_t)(((b * 3 + gi) * 8 + hh) * 4096 + dil_pos(gi, t))) * 64 + dim;
                        gst<u32x4>(dst, pack8(v));
                    }
                }
            }
    }
};
struct EpiOddV {
    static constexpr bool PERM = true;
    bf16_t* vc;
    __device__ __forceinline__ void operator()(const f32x4 (&acc)[2][2][4][2], const Unit& u, int wr, int wc, int fr, int fq) const {
        const int gi = u.pm >> 1;
#pragma unroll
        for (int ai = 0; ai < 2; ++ai)
#pragma unroll
            for (int m = 0; m < 4; ++m) {
                const int r = u.pm * 256 + ai * 128 + wr * 64 + m * 16 + fr, rr = r & 511;
#pragma unroll
                for (int bj = 0; bj < 2; ++bj) {
                    const int c8 = u.pn * 256 + bj * 128 + wc * 32 + 8 * fq;
                    const int b = c8 >> 12, t = c8 & 4095;
                    float v[8]; acc8(acc, ai, bj, m, v);
                    bf16_t* base = vc + ((size_t)((b * 3 + gi) * 8 + (rr >> 6))) * (4096 * 64) + (rr & 63) * 4;
                    const u32x4 o = pack8(v);
                    if (gi == 0) { bf16_t* d0 = base + (size_t)(t >> 2) * 256; gst<u32x2>(d0, (u32x2){o.x, o.y}); gst<u32x2>(d0 + 256, (u32x2){o.z, o.w}); }
                    else {
                        const unsigned w[4] = {o.x, o.y, o.z, o.w};
#pragma unroll
                        for (int i = 0; i < 8; ++i) { const int pos = dil_pos(gi, t + i); gst<bf16_t>(base + (size_t)(pos >> 2) * 256 + (pos & 3), (bf16_t)((i & 1) ? (w[i >> 1] >> 16) : (w[i >> 1] & 0xffffu))); }
                    }
                }
            }
    }
};
struct EpiResid {
    static constexpr bool PERM = false;
    const float* xin; float* xout; const float* gate;
    __device__ __forceinline__ void operator()(const f32x4 (&acc)[2][2][4][2], const Unit& u, int wr, int wc, int fr, int fq) const {
#pragma unroll
        for (int ai = 0; ai < 2; ++ai)
#pragma unroll
            for (int m = 0; m < 4; ++m) {
                const int r = u.pm * 256 + ai * 128 + wr * 64 + m * 16 + fr, b = r >> 12;
#pragma unroll
                for (int bj = 0; bj < 2; ++bj)
#pragma unroll
                    for (int n = 0; n < 2; ++n) {
                        const int c = u.pn * 256 + bj * 128 + wc * 32 + 16 * n + 4 * fq;
                        const f32x4 gv = gld<f32x4>(gate + (size_t)b * 6144 + c);
                        const f32x4 xv = gld<f32x4>(xin + (size_t)r * DM + c);
                        gst<f32x4>(xout + (size_t)r * DM + c, xv + gv * acc[ai][bj][m][n]);
                    }
            }
    }
};
struct EpiBf16 {
    static constexpr bool PERM = true;
    bf16_t* O; int ldc;
    __device__ __forceinline__ void operator()(const f32x4 (&acc)[2][2][4][2], const Unit& u, int wr, int wc, int fr, int fq) const {
#pragma unroll
        for (int ai = 0; ai < 2; ++ai)
#pragma unroll
            for (int m = 0; m < 4; ++m) {
                const int r = u.pm * 256 + ai * 128 + wr * 64 + m * 16 + fr;
#pragma unroll
                for (int bj = 0; bj < 2; ++bj) {
                    const int c8 = u.pn * 256 + bj * 128 + wc * 32 + 8 * fq;
                    float v[8]; acc8(acc, ai, bj, m, v);
                    gst<u32x4>(O + (size_t)r * ldc + c8, pack8(v));
                }
            }
    }
};

__device__ __forceinline__ float rot_up(float v) { return __int_as_float(__builtin_amdgcn_update_dpp(0, __float_as_int(v), 0x121, 0xf, 0xf, false)); }
__device__ __forceinline__ float rot_dn(float v) { return __int_as_float(__builtin_amdgcn_update_dpp(0, __float_as_int(v), 0x12F, 0xf, 0xf, false)); }
struct EpiFfnUp {
    static constexpr bool PERM = true;
    bf16_t* U; float* HG; float* HV; const float* cw; const float* cb;
    __device__ __forceinline__ void operator()(const f32x4 (&acc)[2][2][4][2], const Unit& u, int wr, int wc, int fr, int fq) const {
        const int f8 = u.pn * 128 + wc * 32 + 8 * fq;
#pragma unroll
        for (int ai = 0; ai < 2; ++ai) {
            const int span = u.pm * 4 + ai * 2 + wr, r0 = span * 64;
#pragma unroll
            for (int n = 0; n < 2; ++n) {
                unsigned pk[4][2];
#pragma unroll
                for (int jh = 0; jh < 2; ++jh) {
                    const int j0 = 2 * jh, f = f8 + 4 * n + j0;
                    const f32x2 w0 = gld<f32x2>(cw + f), w1 = gld<f32x2>(cw + DFF + f), w2 = gld<f32x2>(cw + 2 * DFF + f), bb = gld<f32x2>(cb + f);
                    float o[2][4];
#pragma unroll
                    for (int h = 0; h < 2; ++h) {
                        float G[4], ru[4], rd[4];
#pragma unroll
                        for (int m = 0; m < 4; ++m) { G[m] = acc[ai][0][m][n][j0 + h]; ru[m] = rot_up(G[m]); rd[m] = rot_dn(G[m]); }
#pragma unroll
                        for (int m = 0; m < 4; ++m) {
                            const float up = fr > 0 ? ru[m] : (m > 0 ? ru[m > 0 ? m - 1 : 0] : 0.f);
                            const float dn = fr < 15 ? rd[m] : (m < 3 ? rd[m < 3 ? m + 1 : 3] : 0.f);
                            const float gt = bb[h] + up * w0[h] + G[m] * w1[h] + dn * w2[h];
                            o[h][m] = siluf_(gt) * acc[ai][1][m][n][j0 + h];
                        }
                    }
#pragma unroll
                    for (int m = 0; m < 4; ++m) pk[m][jh] = pk2(o[0][m], o[1][m]);
                    if (fr >= 14) {
                        gst<f32x2>(HG + ((size_t)span * 4 + (fr - 14)) * DFF + f, (f32x2){acc[ai][0][3][n][j0], acc[ai][0][3][n][j0 + 1]});
                        if (fr == 15) gst<f32x2>(HV + ((size_t)span * 2 + 0) * DFF + f, (f32x2){acc[ai][1][3][n][j0], acc[ai][1][3][n][j0 + 1]});
                    } else if (fr <= 1) {
                        gst<f32x2>(HG + ((size_t)span * 4 + 2 + fr) * DFF + f, (f32x2){acc[ai][0][0][n][j0], acc[ai][0][0][n][j0 + 1]});
                        if (fr == 0) gst<f32x2>(HV + ((size_t)span * 2 + 1) * DFF + f, (f32x2){acc[ai][1][0][n][j0], acc[ai][1][0][n][j0 + 1]});
                    }
                }
#pragma unroll
                for (int m = 0; m < 4; ++m) {
                    const bool edge = (m == 0 && fr == 0) || (m == 3 && fr == 15);
                    if (!edge) { u32x2 o2; o2.x = pk[m][0]; o2.y = pk[m][1]; gst<u32x2>(U + (size_t)(r0 + 16 * m + fr) * DFF + f8 + 4 * n, o2); }
                }
            }
        }
    }
};

__device__ __forceinline__ float wave_sum64(float v) {
#pragma unroll
    for (int o = 1; o < 64; o <<= 1) v += shx(v, o);
    return v;
}

__device__ __forceinline__ void tr_store(bf16_t* dst, int ldk, int k0, int dr0, const float* lds, int tid) {
    const int n = tid >> 3, kk = (tid & 7) * 8;
    float v[8];
#pragma unroll
    for (int j = 0; j < 8; ++j) v[j] = lds[(kk + j) * 65 + n];
    *(u32x4*)(dst + (size_t)(dr0 + n) * ldk + k0 + kk) = pack8(v);
}
__device__ __forceinline__ void tr_tile(const float* src, int ldn, int k0, int sc0, bf16_t* dst, int ldk, int dr0, float* lds, int tid) {
#pragma unroll
    for (int i = 0; i < 2; ++i) {
        const int r = (tid >> 4) + 32 * i, c4 = (tid & 15) * 4;
        const f32x4 v = gld_nt<f32x4>(src + (size_t)(k0 + r) * ldn + sc0 + c4);
        lds[r * 65 + c4 + 0] = v[0]; lds[r * 65 + c4 + 1] = v[1]; lds[r * 65 + c4 + 2] = v[2]; lds[r * 65 + c4 + 3] = v[3];
    }
    __syncthreads();
    tr_store(dst, ldk, k0, dr0, lds, tid);
    __syncthreads();
}
__device__ __forceinline__ void fold_tile(const float* pw, const float* ps, const float* wout, int k0, int n0, bf16_t* dst, float* lds, int tid) {
    const int c4 = (tid & 15) * 4;
#pragma unroll
    for (int i = 0; i < 2; ++i) {
        const int r = (tid >> 4) + 32 * i, kk = k0 + r - 512, g = kk >> 7, cc = kk & 127;
        const float* pwr = pw + ((size_t)(g * 128 + cc)) * 128;
        const float* psr = ps + g * 128;
        const float* wr_ = wout + (size_t)(512 + g * 128) * 1024 + n0 + c4;
        f32x4 a = {0.f, 0.f, 0.f, 0.f};
        for (int d = 0; d < 128; ++d) { const float s = pwr[d] * psr[d]; const f32x4 w4 = *(const f32x4*)(wr_ + (size_t)d * 1024); a += w4 * s; }
        lds[r * 65 + c4 + 0] = a[0]; lds[r * 65 + c4 + 1] = a[1]; lds[r * 65 + c4 + 2] = a[2]; lds[r * 65 + c4 + 3] = a[3];
    }
    __syncthreads();
    tr_store(dst, 1024, k0, n0, lds, tid);
    __syncthreads();
}
__device__ void convert_layer(const Params& p, int l, unsigned char* shm, int first_block, int nblocks) {
    float* lds = (float*)shm;
    const int tid = otid(), e = l >> 1, odd = l & 1;
    unsigned char* wb = p.ws + (size_t)(l % 3) * SZ_WSET;
    bf16_t* win = (bf16_t*)(wb + OFF_WIN); bf16_t* wout = (bf16_t*)(wb + OFF_WOUT); bf16_t* wup = (bf16_t*)(wb + OFF_WUP); bf16_t* wdn = (bf16_t*)(wb + OFF_WDN);
    const int nin = odd ? 5120 : 4096;
    const int T_IN = 16 * (nin / 64), T_OUT = 256, T_UP = 16 * 88, T_DN = 44 * 16;
    const int total = T_IN + T_OUT + T_UP + T_DN;
    for (int it = obid() - first_block; it < total; it += nblocks) {
        int r = it;
        if (r < T_IN) {
            const int nb = r >> 4, kb = r & 15, n0 = nb * 64;
            int sc0 = n0;
            if (odd) { if (n0 >= 3584) sc0 = n0 - 512; else if (n0 >= 3072) sc0 = n0 + 1536; }
            const float* src = odd ? p.owin + (size_t)e * 1024 * 5120 : p.ewin + (size_t)e * 1024 * 4096;
            tr_tile(src, nin, kb * 64, sc0, win, 1024, n0, lds, tid); continue;
        }
        r -= T_IN;
        if (r < T_OUT) {
            const int nb = r >> 4, kb = r & 15;
            const float* src = odd ? p.owout + (size_t)e * 1024 * 1024 : p.ewout + (size_t)e * 1024 * 1024;
            if (odd && kb >= 8) fold_tile(p.poolw + (size_t)e * 4 * 128 * 128, p.pools + (size_t)e * 512, src, kb * 64, nb * 64, wout, lds, tid);
            else tr_tile(src, 1024, kb * 64, nb * 64, wout, 1024, nb * 64, lds, tid);
            continue;
        }
        r -= T_OUT;
        if (r < T_UP) { const int nb = r >> 4, kb = r & 15, n0 = nb * 64, tile = n0 >> 8, within = n0 & 255;
            const int sc0 = within < 128 ? 128 * tile + within : DFF + 128 * tile + within - 128;
            tr_tile(p.wup + (size_t)l * 1024 * 5632, 5632, kb * 64, sc0, wup, 1024, n0, lds, tid); continue; }
        r -= T_UP;
        { const int nb = r / 44, kb = r % 44; tr_tile(p.wdn + (size_t)l * 2816 * 1024, 1024, kb * 64, nb * 64, wdn, 2816, nb * 64, lds, tid); }
    }
}

__device__ void prep_mod(const Params& p, unsigned char* shm) {
    float* cact = (float*)shm;
    float* red = (float*)(shm + 32768);
    float* mod = (float*)(p.ws + OFF_MOD);
    const int tid = otid(), w = tid >> 6, lane = tid & 63;
    if (obid() == gridDim.x - 1) {
        float* lbp = (float*)(p.ws + OFF_LB);
        const float a = p.lblog[tid], b = p.lblog[512 + tid], mx = fmaxf(a, b), ea = __expf(a - mx), eb = __expf(b - mx);
        lbp[tid] = 0.f; lbp[512 + tid] = eb / (ea + eb);
    }
    for (int i = tid; i < 8192; i += 512) cact[i] = siluf_(p.c[i]);
    __syncthreads();
    for (int item = obid(); item < 4 * 96; item += gridDim.x) {
        const int l = item / 96, n0 = (item % 96) * 64;
        float a[8];
#pragma unroll
        for (int b = 0; b < 8; ++b) a[b] = 0.f;
        const float* wp = p.ada_w + ((size_t)l * 1024 + w * 128) * 6144 + n0 + lane;
#pragma unroll 2
        for (int k = 0; k < 128; k += 4) {
            float wv[4];
#pragma unroll
            for (int j = 0; j < 4; ++j) wv[j] = gld_nt<float>(wp + (size_t)(k + j) * 6144);
#pragma unroll
            for (int b = 0; b < 8; ++b) {
                const f32x4 c4 = *(const f32x4*)(cact + b * 1024 + w * 128 + k);
                a[b] += c4[0] * wv[0] + c4[1] * wv[1] + c4[2] * wv[2] + c4[3] * wv[3];
            }
        }
#pragma unroll
        for (int b = 0; b < 8; ++b) red[(w * 8 + b) * 64 + lane] = a[b];
        __syncthreads();
        {
            const int b = tid >> 6;
            float s = p.ada_b[l * 6144 + n0 + lane];
#pragma unroll
            for (int ww = 0; ww < 8; ++ww) s += red[(ww * 8 + b) * 64 + lane];
            mod[((size_t)(l * 8 + b)) * 6144 + n0 + lane] = s;
        }
        __syncthreads();
    }
}

__device__ void norm_rows(const float* xin, const float* g, const float* modl, int sh_off, int sc_off, bf16_t* hb) {
    const int w = otid() >> 6, lane = otid() & 63;
    for (int row = obid() * 8 + w; row < MTOK; row += gridDim.x * 8) {
        const int b = row >> 12;
        const float* xr = xin + (size_t)row * DM;
        f32x4 v[4]; float ss = 0.f;
#pragma unroll
        for (int i = 0; i < 2; ++i) { v[2 * i] = gld_nt<f32x4>(xr + 512 * i + 8 * lane); v[2 * i + 1] = gld_nt<f32x4>(xr + 512 * i + 8 * lane + 4); }
#pragma unroll
        for (int i = 0; i < 4; ++i) ss += v[i][0] * v[i][0] + v[i][1] * v[i][1] + v[i][2] * v[i][2] + v[i][3] * v[i][3];
        const float rstd = rsqrtf(wave_sum64(ss) * (1.0f / DM) + RMS_EPS);
        const float* mb = modl + (size_t)b * 6144;
#pragma unroll
        for (int i = 0; i < 2; ++i) {
            const int c = 512 * i + 8 * lane;
            float o[8];
#pragma unroll
            for (int h2 = 0; h2 < 2; ++h2) {
                const f32x4 gv = *(const f32x4*)(g + c + 4 * h2), sc = *(const f32x4*)(mb + sc_off + c + 4 * h2), sh = *(const f32x4*)(mb + sh_off + c + 4 * h2);
#pragma unroll
                for (int j = 0; j < 4; ++j) o[4 * h2 + j] = v[2 * i + h2][j] * rstd * gv[j] * (1.0f + sc[j]) + sh[j];
            }
            *(u32x4*)(hb + (size_t)row * DM + c) = pack8(o);
        }
    }
}
__device__ void final_norm(float* x, const float* g) {
    const int w = otid() >> 6, lane = otid() & 63;
    for (int row = obid() * 8 + w; row < MTOK; row += gridDim.x * 8) {
        float* xr = x + (size_t)row * DM;
        f32x4 v[4]; float ss = 0.f;
#pragma unroll
        for (int i = 0; i < 4; ++i) { v[i] = gld_nt<f32x4>(xr + 256 * i + 4 * lane); ss += v[i][0] * v[i][0] + v[i][1] * v[i][1] + v[i][2] * v[i][2] + v[i][3] * v[i][3]; }
        const float rstd = rsqrtf(wave_sum64(ss) * (1.0f / DM) + RMS_EPS);
#pragma unroll
        for (int i = 0; i < 4; ++i) { const f32x4 gv = *(const f32x4*)(g + 256 * i + 4 * lane); *(f32x4*)(xr + 256 * i + 4 * lane) = v[i] * rstd * gv; }
    }
}

struct AttnState { f32x4 o[4]; float m, l; };
template <int NP>
__device__ __forceinline__ void attn_stepN(AttnState& st, const float (&s)[8 * NP], const bf16x8 (&vf)[NP][4]) {
    float mx = s[0];
#pragma unroll
    for (int i = 1; i < 8 * NP; ++i) mx = fmaxf(mx, s[i]);
    mx = fmaxf(mx, shx(mx, 16)); mx = fmaxf(mx, shx(mx, 32));
    const float mn = fmaxf(fmaxf(st.m, mx), -1e20f), alpha = __builtin_amdgcn_exp2f(st.m - mn);
    float ps = 0.f; bf16x8 pf[NP];
#pragma unroll
    for (int np = 0; np < NP; ++np) {
        float pv[8];
#pragma unroll
        for (int i = 0; i < 8; ++i) { pv[i] = __builtin_amdgcn_exp2f(s[8 * np + i] - mn); ps += pv[i]; }
        pf[np] = mk8u(pk2(pv[0], pv[1]), pk2(pv[2], pv[3]), pk2(pv[4], pv[5]), pk2(pv[6], pv[7]));
    }
    st.l = st.l * alpha + ps; st.m = mn;
#pragma unroll
    for (int dt = 0; dt < 4; ++dt) {
        st.o[dt] *= alpha;
#pragma unroll
        for (int np = 0; np < NP; ++np) st.o[dt] = mfma16(vf[np][dt], pf[np], st.o[dt]);
    }
}
__device__ __forceinline__ void attn_finish(AttnState& st, bf16_t* dst  ) {
    float l = st.l; l += shx(l, 16); l += shx(l, 32);
    const float inv = 1.0f / l;
#pragma unroll
    for (int dt = 0; dt < 4; ++dt) { u32x2 o; o.x = pk2(st.o[dt][0] * inv, st.o[dt][1] * inv); o.y = pk2(st.o[dt][2] * inv, st.o[dt][3] * inv); gst<u32x2>(dst + 16 * dt, o); }
}

__device__ void na_task(const Params& p, int e, int tk, int  ) {
    const int lane = otid() & 63, fr = lane & 15, fq = lane >> 4;
    const int seg = tk & 3, r = (tk >> 2) & 63, hh = (tk >> 8) & 7, b = tk >> 11, bh = b * 8 + hh;
    const bf16_t* qn = (const bf16_t*)(p.ws + OFF_ZB + ZE_QN) + (size_t)bh * 4096 * 64;
    const bf16_t* kn = (const bf16_t*)(p.ws + OFF_ZB + ZE_KN) + (size_t)bh * 4096 * 64;
    const bf16_t* vn = (const bf16_t*)(p.ws + OFF_ZB + ZE_VN) + (size_t)bh * 64 * 4096;
    const float* rpb = p.rpb + (size_t)(e * 8 + hh) * 15 * 31;
    const int c0 = 16 * seg, cw = seg == 0 ? 0 : (seg == 1 ? 8 : (seg == 2 ? 24 : 32));
    const int rs = min(max(r - 4, 0), 56);
    const int c = c0 + fr, cs = min(max(c - 8, 0), 48);
    const int dcol = cw + 4 * fq - c + 15, wlo = cs - c + 15;
    const bf16_t* qrow = qn + (size_t)(r * 64 + c) * 64 + 8 * fq;
    const bf16x8 q0 = gld<bf16x8>(qrow), q1 = gld<bf16x8>(qrow + 32);
    AttnState st;
#pragma unroll
    for (int dt = 0; dt < 4; ++dt) st.o[dt] = (f32x4){0.f, 0.f, 0.f, 0.f};
    st.m = NEG_BIG; st.l = 0.f;
#pragma unroll 1
    for (int i0 = 0; i0 < 8; i0 += 4) {
        bf16x8 kf[4][4], vf[4][4];
#pragma unroll
        for (int ii = 0; ii < 4; ++ii) {
            const int tk0 = (rs + i0 + ii) * 64 + cw;
            const bf16_t* k0p = kn + (size_t)(tk0 + fr) * 64 + 8 * fq;
            kf[ii][0] = gld<bf16x8>(k0p); kf[ii][1] = gld<bf16x8>(k0p + 32); kf[ii][2] = gld<bf16x8>(k0p + 16 * 64); kf[ii][3] = gld<bf16x8>(k0p + 16 * 64 + 32);
#pragma unroll
            for (int dt = 0; dt < 4; ++dt) { const bf16_t* vp = vn + (size_t)((tk0 >> 2) + fq) * 256 + (16 * dt + fr) * 4; vf[ii][dt] = mk8(gld<u32x2>(vp), gld<u32x2>(vp + 4 * 256)); }
        }
        float s[32];
#pragma unroll
        for (int ii = 0; ii < 4; ++ii) {
            const int krow = rs + i0 + ii;
            f32x4 s0 = {0.f, 0.f, 0.f, 0.f}, s1 = {0.f, 0.f, 0.f, 0.f};
            s0 = mfma16(kf[ii][0], q0, s0); s0 = mfma16(kf[ii][1], q1, s0);
            s1 = mfma16(kf[ii][2], q0, s1); s1 = mfma16(kf[ii][3], q1, s1);
            const float* rb = rpb + (krow - r + 7) * 31;
#pragma unroll
            for (int j = 0; j < 4; ++j) {
                const int d0 = dcol + j, d1 = d0 + 16;
                const float b0 = gld<float>(rb + min(max(d0, 0), 30)), b1 = gld<float>(rb + min(max(d1, 0), 30));
                s[8 * ii + j] = ((unsigned)(d0 - wlo) <= 15u) ? fmaf(b0, LOG2E, s0[j]) : NEG_BIG;
                s[8 * ii + 4 + j] = ((unsigned)(d1 - wlo) <= 15u) ? fmaf(b1, LOG2E, s1[j]) : NEG_BIG;
            }
        }
        attn_stepN<4>(st, s, vf);
    }
    bf16_t* hb = (bf16_t*)(p.ws + OFF_HB);
    attn_finish(st, hb + (size_t)(b * 4096 + r * 64 + c) * DM + 512 + hh * 64 + 4 * fq);
}

constexpr int DKS = 72, DVS = 392, DIL_VS_OFF = 384 * DKS * 2;
struct DilRegs { u32x4 k[6]; u32x4 v[6]; };
__device__ __forceinline__ void dil_stage_load(DilRegs& R, const bf16_t* kc_g, const bf16_t* vc_g, int tid, int nkeys, int L_, int cb0, int cbs, int ustart) {
#pragma unroll
    for (int i = 0; i < 6; ++i) {
        const int c = tid + 512 * i;
        { const int row = c >> 3, part = c & 7, s = row >= nkeys ? 1 : 0, k = row - s * nkeys, uc = min(max(ustart + k, 0), L_ - 1);
          R.k[i] = gld<u32x4>(kc_g + (size_t)(cb0 + s * cbs + uc) * 64 + part * 8); }
        { const int g = c >> 5, dvp = c & 31, col = 4 * g, s = col >= nkeys ? 1 : 0, k = col - s * nkeys, uc = min(max(ustart + k, 0), L_ - 4);
          R.v[i] = gld<u32x4>(vc_g + ((size_t)((cb0 + s * cbs + uc) >> 2) * 64 + 2 * dvp) * 4); }
    }
}
__device__ __forceinline__ void dil_stage_store(const DilRegs& R, unsigned char* shm, int tid) {
    bf16_t* KS = (bf16_t*)shm; bf16_t* VS = (bf16_t*)(shm + DIL_VS_OFF);
#pragma unroll
    for (int i = 0; i < 6; ++i) {
        const int c = tid + 512 * i;
        { const int row = c >> 3, part = c & 7; *(u32x4*)(KS + row * DKS + part * 8) = R.k[i]; }
        { const int g = c >> 5, dvp = c & 31; *(u32x2*)(VS + (2 * dvp) * DVS + 4 * g) = (u32x2){R.v[i].x, R.v[i].y}; *(u32x2*)(VS + (2 * dvp + 1) * DVS + 4 * g) = (u32x2){R.v[i].z, R.v[i].w}; }
    }
}
__device__ __forceinline__ void dil_lds_group(AttnState& st, const unsigned char* shm, int rowbase, int npair, int ustart, int uq, int L_, float slope_d, const bf16_t* qrow, int fr, int fq) {
    const bf16_t* KS = (const bf16_t*)shm; const bf16_t* VS = (const bf16_t*)(shm + DIL_VS_OFF);
    const bf16x8 q0 = gld<bf16x8>(qrow), q1 = gld<bf16x8>(qrow + 32);
    const float dbase = (float)(ustart + 4 * fq - uq), dlo = (float)max(-64, -uq), dhi = (float)min(64, L_ - 1 - uq);
#pragma unroll 1
    for (int pi0 = 0; pi0 < npair; pi0 += 2) {
        bf16x8 kf[2][4], vf[2][4];
#pragma unroll
        for (int ii = 0; ii < 2; ++ii) {
            const int kl0 = rowbase + 32 * (pi0 + ii);
            const bf16_t* kap = KS + (kl0 + fr) * DKS + 8 * fq;
            kf[ii][0] = *(const bf16x8*)kap; kf[ii][1] = *(const bf16x8*)(kap + 32); kf[ii][2] = *(const bf16x8*)(kap + 16 * DKS); kf[ii][3] = *(const bf16x8*)(kap + 16 * DKS + 32);
#pragma unroll
            for (int dt = 0; dt < 4; ++dt) { const bf16_t* vp = VS + (16 * dt + fr) * DVS + kl0 + 4 * fq; vf[ii][dt] = mk8(*(const u32x2*)vp, *(const u32x2*)(vp + 16)); }
        }
        float s[16];
#pragma unroll
        for (int ii = 0; ii < 2; ++ii) {
            f32x4 s0 = {0.f, 0.f, 0.f, 0.f}, s1 = {0.f, 0.f, 0.f, 0.f};
            s0 = mfma16(kf[ii][0], q0, s0); s0 = mfma16(kf[ii][1], q1, s0);
            s1 = mfma16(kf[ii][2], q0, s1); s1 = mfma16(kf[ii][3], q1, s1);
#pragma unroll
            for (int j = 0; j < 4; ++j) {
                const float da = dbase + (float)(32 * (pi0 + ii) + j), db = da + 16.f;
                s[8 * ii + j] = (da >= dlo && da <= dhi) ? fmaf(-slope_d, fabsf(da), s0[j]) : NEG_BIG;
                s[8 * ii + 4 + j] = (db >= dlo && db <= dhi) ? fmaf(-slope_d, fabsf(db), s1[j]) : NEG_BIG;
            }
        }
        attn_stepN<2>(st, s, vf);
    }
}
__device__ __forceinline__ void dil_lds_group_ab(AttnState& sa, AttnState& sb, const unsigned char* shm, int npair, int ustart, int uqa, int uqb, int L_, float slope_d,
                                                 const bf16_t* qrow_a, const bf16_t* qrow_b, int fr, int fq) {
    const bf16_t* KS = (const bf16_t*)shm; const bf16_t* VS = (const bf16_t*)(shm + DIL_VS_OFF);
    const bf16x8 qa0 = gld<bf16x8>(qrow_a), qa1 = gld<bf16x8>(qrow_a + 32), qb0 = gld<bf16x8>(qrow_b), qb1 = gld<bf16x8>(qrow_b + 32);
    const float dba = (float)(ustart + 4 * fq - uqa), dloa = (float)max(-64, -uqa), dhia = (float)min(64, L_ - 1 - uqa);
    const float dbb = (float)(ustart + 4 * fq - uqb), dlob = (float)max(-64, -uqb), dhib = (float)min(64, L_ - 1 - uqb);
#pragma unroll 1
    for (int pi0 = 0; pi0 < npair; pi0 += 2) {
        bf16x8 kf[2][4], vf[2][4];
#pragma unroll
        for (int ii = 0; ii < 2; ++ii) {
            const int kl0 = 32 * (pi0 + ii);
            const bf16_t* kap = KS + (kl0 + fr) * DKS + 8 * fq;
            kf[ii][0] = *(const bf16x8*)kap; kf[ii][1] = *(const bf16x8*)(kap + 32); kf[ii][2] = *(const bf16x8*)(kap + 16 * DKS); kf[ii][3] = *(const bf16x8*)(kap + 16 * DKS + 32);
#pragma unroll
            for (int dt = 0; dt < 4; ++dt) { const bf16_t* vp = VS + (16 * dt + fr) * DVS + kl0 + 4 * fq; vf[ii][dt] = mk8(*(const u32x2*)vp, *(const u32x2*)(vp + 16)); }
        }
        float s_a[16], s_b[16];
#pragma unroll
        for (int ii = 0; ii < 2; ++ii) {
            f32x4 a0 = {0.f, 0.f, 0.f, 0.f}, a1 = {0.f, 0.f, 0.f, 0.f}, b0 = {0.f, 0.f, 0.f, 0.f}, b1 = {0.f, 0.f, 0.f, 0.f};
            a0 = mfma16(kf[ii][0], qa0, a0); b0 = mfma16(kf[ii][0], qb0, b0); a1 = mfma16(kf[ii][2], qa0, a1); b1 = mfma16(kf[ii][2], qb0, b1);
            a0 = mfma16(kf[ii][1], qa1, a0); b0 = mfma16(kf[ii][1], qb1, b0); a1 = mfma16(kf[ii][3], qa1, a1); b1 = mfma16(kf[ii][3], qb1, b1);
#pragma unroll
            for (int j = 0; j < 4; ++j) {
                const float off = (float)(32 * (pi0 + ii) + j);
                const float da = dba + off, da2 = da + 16.f, db = dbb + off, db2 = db + 16.f;
                s_a[8 * ii + j] = (da >= dloa && da <= dhia) ? fmaf(-slope_d, fabsf(da), a0[j]) : NEG_BIG;
                s_a[8 * ii + 4 + j] = (da2 >= dloa && da2 <= dhia) ? fmaf(-slope_d, fabsf(da2), a1[j]) : NEG_BIG;
                s_b[8 * ii + j] = (db >= dlob && db <= dhib) ? fmaf(-slope_d, fabsf(db), b0[j]) : NEG_BIG;
                s_b[8 * ii + 4 + j] = (db2 >= dlob && db2 <= dhib) ? fmaf(-slope_d, fabsf(db2), b1[j]) : NEG_BIG;
            }
        }
        attn_stepN<2>(sa, s_a, vf);
        attn_stepN<2>(sb, s_b, vf);
    }
}
template <int NP>
__device__ __forceinline__ void dil_g2_step(AttnState& sa, AttnState& sb, const bf16_t* kc2, const bf16_t* vc2, int cba, int cbb, int uqa, int uqb, int ubeg, float sl2,
                                            bf16x8 qa0, bf16x8 qa1, bf16x8 qb0, bf16x8 qb1, int fr, int fq) {
    bf16x8 kf[2][NP][4], vf[2][NP][4];
#pragma unroll
    for (int x = 0; x < 2; ++x) {
        const int cb = x ? cbb : cba;
#pragma unroll
        for (int ii = 0; ii < NP; ++ii) {
            const int u0 = ubeg + 32 * ii;
            const int ka = min(max(u0 + fr, 0), 255), kb = min(max(u0 + 16 + fr, 0), 255);
            const int ug0 = min(max(u0 + 4 * fq, 0), 252), ug1 = min(max(u0 + 16 + 4 * fq, 0), 252);
            const bf16_t* kap = kc2 + (size_t)(cb + ka) * 64 + 8 * fq; const bf16_t* kbp = kc2 + (size_t)(cb + kb) * 64 + 8 * fq;
            kf[x][ii][0] = gld<bf16x8>(kap); kf[x][ii][1] = gld<bf16x8>(kap + 32); kf[x][ii][2] = gld<bf16x8>(kbp); kf[x][ii][3] = gld<bf16x8>(kbp + 32);
#pragma unroll
            for (int dt = 0; dt < 4; ++dt) { const bf16_t* vp = vc2 + (16 * dt + fr) * 4; vf[x][ii][dt] = mk8(gld<u32x2>(vp + (size_t)((cb + ug0) >> 2) * 256), gld<u32x2>(vp + (size_t)((cb + ug1) >> 2) * 256)); }
        }
    }
#pragma unroll
    for (int x = 0; x < 2; ++x) {
        const int uq = x ? uqb : uqa;
        float s[8 * NP];
        const float dbase = (float)(ubeg + 4 * fq - uq), dlo = (float)max(-64, -uq), dhi = (float)min(64, 255 - uq);
#pragma unroll
        for (int ii = 0; ii < NP; ++ii) {
            f32x4 s0 = {0.f, 0.f, 0.f, 0.f}, s1 = {0.f, 0.f, 0.f, 0.f};
            s0 = mfma16(kf[x][ii][0], x ? qb0 : qa0, s0); s0 = mfma16(kf[x][ii][1], x ? qb1 : qa1, s0);
            s1 = mfma16(kf[x][ii][2], x ? qb0 : qa0, s1); s1 = mfma16(kf[x][ii][3], x ? qb1 : qa1, s1);
#pragma unroll
            for (int j = 0; j < 4; ++j) {
                const float da = dbase + (float)(32 * ii + j), db = da + 16.f;
                s[8 * ii + j] = (da >= dlo && da <= dhi) ? fmaf(-sl2, fabsf(da), s0[j]) : NEG_BIG;
                s[8 * ii + 4 + j] = (db >= dlo && db <= dhi) ? fmaf(-sl2, fabsf(db), s1[j]) : NEG_BIG;
            }
        }
        attn_stepN<NP>(x ? sb : sa, s, vf[x]);
    }
}
__device__ __forceinline__ void dil_g2(AttnState& sa, AttnState& sb, const bf16_t* kc2, const bf16_t* vc2, const bf16_t* qc2, int cba, int cbb, int uqa, int uqb, int ustart, float sl2, int fr, int fq) {
    const bf16_t* qra = qc2 + (size_t)(cba + uqa) * 64 + 8 * fq; const bf16_t* qrb = qc2 + (size_t)(cbb + uqb) * 64 + 8 * fq;
    const bf16x8 qa0 = gld<bf16x8>(qra), qa1 = gld<bf16x8>(qra + 32), qb0 = gld<bf16x8>(qrb), qb1 = gld<bf16x8>(qrb + 32);
    dil_g2_step<2>(sa, sb, kc2, vc2, cba, cbb, uqa, uqb, ustart, sl2, qa0, qa1, qb0, qb1, fr, fq);
    dil_g2_step<2>(sa, sb, kc2, vc2, cba, cbb, uqa, uqb, ustart + 64, sl2, qa0, qa1, qb0, qb1, fr, fq);
    dil_g2_step<1>(sa, sb, kc2, vc2, cba, cbb, uqa, uqb, ustart + 128, sl2, qa0, qa1, qb0, qb1, fr, fq);
}
__device__ __forceinline__ float dil_slope(int gi, int hh) { return exp2f(-8.0f * (float)(gi * 8 + hh + 1) / 24.0f) * (float)(1 << (2 * gi)) * LOG2E; }
__device__ __forceinline__ void dil_stage(unsigned char* shm, const bf16_t* kc_g, const bf16_t* vc_g, int  , int nkeys, int L_, int cb0, int cbs, int ustart) {
    DilRegs R;
    const int tid = otid();
    __syncthreads();
    dil_stage_load(R, kc_g, vc_g, tid, nkeys, L_, cb0, cbs, ustart);
    dil_stage_store(R, shm, tid);
    __syncthreads();
}
__device__ void dil_block(const Params& p, unsigned char* shm) {
    const bf16_t* QC = (const bf16_t*)(p.ws + OFF_ZB + ZO_QC); const bf16_t* KC = (const bf16_t*)(p.ws + OFF_ZB + ZO_KC); const bf16_t* VC = (const bf16_t*)(p.ws + OFF_ZB + ZO_VC);
    bf16_t* hb = (bf16_t*)(p.ws + OFF_HB);
    const int G = gridDim.x;
    for (int task = obid(); task < 1024; task += G) {
        const int tid = otid(), lane = tid & 63, w = __builtin_amdgcn_readfirstlane(tid >> 6), fr = lane & 15, fq = lane >> 4;
        const int rho_a = 4 * (w >> 1) + (w & 1), rho_b = rho_a + 2, slot = w & 1;
        const int T0 = (task & 15) * 256, hh = (task >> 4) & 7, b = task >> 7;
        const size_t g0 = (size_t)((b * 3 + 0) * 8 + hh), g1 = g0 + 8, g2 = g0 + 16;
        const int tqa = T0 + rho_a + 16 * fr, tqb = T0 + rho_b + 16 * fr;
        AttnState sa, sb;
#pragma unroll
        for (int dt = 0; dt < 4; ++dt) { sa.o[dt] = (f32x4){0.f, 0.f, 0.f, 0.f}; sb.o[dt] = (f32x4){0.f, 0.f, 0.f, 0.f}; }
        sa.m = NEG_BIG; sa.l = 0.f; sb.m = NEG_BIG; sb.l = 0.f;
        dil_stage(shm, KC + g0 * 4096 * 64, VC + g0 * 64 * 4096, tid, 384, 4096, 0, 0, T0 - 64);
        { const float sl = dil_slope(0, hh);
          dil_lds_group_ab(sa, sb, shm, 12, T0 - 64, tqa, tqb, 4096, sl, QC + (g0 * 4096 + tqa) * 64 + 8 * fq, QC + (g0 * 4096 + tqb) * 64 + 8 * fq, fr, fq); }
        dil_stage(shm, KC + g1 * 4096 * 64, VC + g1 * 64 * 4096, tid, 192, 1024, 0, 1024, (T0 >> 2) - 64);
        const float sl1 = dil_slope(1, hh);
        { const int uq = tqa >> 2, cb = (rho_a & 3) * 1024;
          dil_lds_group(sa, shm, slot * 192, 6, (T0 >> 2) - 64, uq, 1024, sl1, QC + (g1 * 4096 + cb + uq) * 64 + 8 * fq, fr, fq); }
        dil_stage(shm, KC + g1 * 4096 * 64, VC + g1 * 64 * 4096, tid, 192, 1024, 2048, 1024, (T0 >> 2) - 64);
        { const int uq = tqb >> 2, cb = (rho_b & 3) * 1024;
          dil_lds_group(sb, shm, slot * 192, 6, (T0 >> 2) - 64, uq, 1024, sl1, QC + (g1 * 4096 + cb + uq) * 64 + 8 * fq, fr, fq); }
        {
            const float sl2 = dil_slope(2, hh);
            const bf16_t* kc2 = KC + g2 * 4096 * 64; const bf16_t* vc2 = VC + g2 * 64 * 4096; const bf16_t* qc2 = QC + g2 * 4096 * 64;
            dil_g2(sa, sb, kc2, vc2, qc2, rho_a * 256, rho_b * 256, tqa >> 4, tqb >> 4, (T0 >> 4) - 64, sl2, fr, fq);
        }
        attn_finish(sa, hb + (size_t)(b * 4096 + tqa) * DM + hh * 64 + 4 * fq);
        attn_finish(sb, hb + (size_t)(b * 4096 + tqb) * DM + hh * 64 + 4 * fq);
    }
    __syncthreads();
}

__device__ void pool_pass(const Params& p, int first_block, int nblocks) {
    const bf16_t* pu = (const bf16_t*)(p.ws + OFF_ZB + ZO_PU);
    bf16_t* hb = (bf16_t*)(p.ws + OFF_HB);
    for (int idx = (obid() - first_block) * 512 + otid(); idx < (MTOK / 16) * 64; idx += nblocks * 512) {
        const int c8 = (idx & 63) * 8, tok0 = (idx >> 6) * 16, gi = c8 >> 7, hw = 1 << gi, t0 = tok0 & 4095, b0 = tok0 - t0;
        const bf16_t* col = pu + (size_t)b0 * 512 + c8;
        float a[8];
#pragma unroll
        for (int i = 0; i < 8; ++i) a[i] = 0.f;
        for (int tt = max(t0 - hw, 0); tt < min(t0 + hw, 4096); ++tt) {
            float v[8]; unpack8(*(const u32x4*)(col + (size_t)tt * 512), v);
#pragma unroll
            for (int i = 0; i < 8; ++i) a[i] += v[i];
        }
#pragma unroll 4
        for (int k = 0; k < 16; ++k) {
            const int t = t0 + k, lo = max(t - hw, 0), hi = min(t + hw, 4096);
            float uv[8]; unpack8(*(const u32x4*)(col + (size_t)t * 512), uv);
            const float inv = 1.0f / (float)(hi - lo);
            float o[8];
#pragma unroll
            for (int i = 0; i < 8; ++i) o[i] = a[i] * inv - uv[i];
            *(u32x4*)(hb + (size_t)(b0 + t) * DM + 512 + c8) = pack8(o);
            if (t + hw < 4096) { float v[8]; unpack8(*(const u32x4*)(col + (size_t)(t + hw) * 512), v);
#pragma unroll
                for (int i = 0; i < 8; ++i) a[i] += v[i]; }
            if (t - hw >= 0) { float v[8]; unpack8(*(const u32x4*)(col + (size_t)(t - hw) * 512), v);
#pragma unroll
                for (int i = 0; i < 8; ++i) a[i] -= v[i]; }
        }
    }
}

__device__ void ffn_fix(const Params& p, int l) {
    bf16_t* U = (bf16_t*)(p.ws + OFF_ZB + ZF_U); const float* HG = (const float*)(p.ws + OFF_ZB + ZF_HG); const float* HV = (const float*)(p.ws + OFF_ZB + ZF_HV);
    const float* cw = p.convw + (size_t)l * 3 * DFF; const float* cb = p.convb + (size_t)l * DFF;
    for (int idx = obid() * 512 + otid(); idx < 352 * 1024; idx += gridDim.x * 512) {
        const int sb = idx / 352, f8 = (idx - sb * 352) * 8, s = sb >> 1, last = sb & 1;
        const int row = 64 * s + (last ? 63 : 0), t = row & 4095;
        const float* gc = HG + ((size_t)s * 4 + (last ? 1 : 2)) * DFF + f8;
        const float* gu = last ? HG + ((size_t)s * 4 + 0) * DFF + f8 : HG + ((size_t)(s - 1) * 4 + 1) * DFF + f8;
        const float* gd = last ? HG + ((size_t)(s + 1) * 4 + 2) * DFF + f8 : HG + ((size_t)s * 4 + 3) * DFF + f8;
        const float* vv = HV + ((size_t)s * 2 + (last ? 0 : 1)) * DFF + f8;
        const bool has_up = last || t > 0, has_dn = !last || t < 4095;
        float o[8];
#pragma unroll
        for (int h = 0; h < 2; ++h) {
            const f32x4 z4 = {0.f, 0.f, 0.f, 0.f};
            const f32x4 c4 = *(const f32x4*)(gc + 4 * h), u4 = has_up ? *(const f32x4*)(gu + 4 * h) : z4, d4 = has_dn ? *(const f32x4*)(gd + 4 * h) : z4, v4 = *(const f32x4*)(vv + 4 * h);
            const f32x4 w0 = *(const f32x4*)(cw + f8 + 4 * h), w1 = *(const f32x4*)(cw + DFF + f8 + 4 * h), w2 = *(const f32x4*)(cw + 2 * DFF + f8 + 4 * h), bb = *(const f32x4*)(cb + f8 + 4 * h);
#pragma unroll
            for (int j = 0; j < 4; ++j) o[4 * h + j] = siluf_(bb[j] + u4[j] * w0[j] + c4[j] * w1[j] + d4[j] * w2[j]) * v4[j];
        }
        *(u32x4*)(U + (size_t)row * DFF + f8) = pack8(o);
    }
}

__device__ void hgrn_combine(const Params& p, int e) {
    const bf16_t* of = (const bf16_t*)(p.ws + OFF_ZB + ZE_OF); const bf16_t* ob = (const bf16_t*)(p.ws + OFF_ZB + ZE_OB);
    const bf16_t* za = (const bf16_t*)(p.ws + OFF_ZB + ZE_ZA);
    bf16_t* hb = (bf16_t*)(p.ws + OFF_HB);
    const int w = otid() >> 6, lane = otid() & 63;
    const float* hg = p.hng + e * 128 + ((8 * lane) & 127);
    for (int tok = obid() * 8 + w; tok < MTOK; tok += gridDim.x * 8) {
        float a[8], bb[8], gs[8];
        unpack8(*(const u32x4*)(of + (size_t)tok * 512 + 8 * lane), a); unpack8(*(const u32x4*)(ob + (size_t)tok * 512 + 8 * lane), bb);
        unpack8(*(const u32x4*)(za + (size_t)tok * ZAW + 2048 + 8 * lane), gs);
        float ss = 0.f;
#pragma unroll
        for (int i = 0; i < 8; ++i) { a[i] += bb[i]; ss += a[i] * a[i]; }
        ss += shx(ss, 1); ss += shx(ss, 2); ss += shx(ss, 4); ss += shx(ss, 8);
        const float rstd = rsqrtf(ss * (1.0f / 128.0f) + RMS_EPS);
#pragma unroll
        for (int i = 0; i < 8; ++i) a[i] = a[i] * rstd * hg[i] * gs[i];
        *(u32x4*)(hb + (size_t)tok * DM + 8 * lane) = pack8(a);
    }
}

__device__ void hgrn_chain(const Params& p, int chain, unsigned char* shm) {
    const int tid = otid(), w = __builtin_amdgcn_readfirstlane(tid >> 6), lane = tid & 63, fr = lane & 15, fq = lane >> 4;
    const int b = chain >> 3, hh = (chain >> 1) & 3, dir = chain & 1;
    bf16_t* QP = (bf16_t*)(shm); bf16_t* QT = (bf16_t*)(shm + 8704); bf16_t* KT = (bf16_t*)(shm + 17408);
    bf16_t* KC = (bf16_t*)(shm + 26112); bf16_t* VC = (bf16_t*)(shm + 36352); bf16_t* ATT = (bf16_t*)(shm + 46592);
    float* DD = (float*)(shm + 49152); float* GT = (float*)(shm + 49664);
    const bf16_t* za = (const bf16_t*)(p.ws + OFF_ZB + ZE_ZA) + (size_t)b * 4096 * ZAW;
    bf16_t* od = (bf16_t*)(p.ws + OFF_ZB + (dir ? ZE_OB : ZE_OF)) + (size_t)b * 4096 * 512 + hh * 128;
    const int qcol = hh * 128 + 2 * lane, lcol = 512 * (1 + dir) + hh * 128 + 2 * lane, vcol = 1536 + hh * 128 + 2 * lane;
    const int Vs = 16 * w;
    for (int i = tid; i < 32 * 40 / 2; i += 512) ((unsigned*)ATT)[i] = 0u;
    f32x4 S[8];
#pragma unroll
    for (int kt = 0; kt < 8; ++kt) S[kt] = (f32x4){0.f, 0.f, 0.f, 0.f};
    unsigned rq[4], rl[4], rv[4];
#pragma unroll
    for (int j = 0; j < 4; ++j) {
        const int s = 4 * w + j, t = dir ? 4095 - s : s;
        const bf16_t* row = za + (size_t)t * ZAW;
        rq[j] = gld<unsigned>(row + qcol); rl[j] = gld<unsigned>(row + lcol); rv[j] = gld<unsigned>(row + vcol);
    }
    {
        float a0 = 0.f, a1 = 0.f;
#pragma unroll
        for (int j = 0; j < 4; ++j) { a0 += bf_lo(rl[j]); a1 += bf_hi(rl[j]); }
        *(f32x2*)(GT + w * 128 + 2 * lane) = (f32x2){a0, a1};
    }
    __syncthreads();
    u32x2 po[2] = {(u32x2){0u, 0u}, (u32x2){0u, 0u}};
    for (int ci = 0; ci < 128; ++ci) {
        unsigned cq[4], cl[4], cv[4];
#pragma unroll
        for (int j = 0; j < 4; ++j) { cq[j] = rq[j]; cl[j] = rl[j]; cv[j] = rv[j]; }
        if (ci + 1 < 128) {
#pragma unroll
            for (int j = 0; j < 4; ++j) {
                const int s = 32 * (ci + 1) + 4 * w + j, t = dir ? 4095 - s : s;
                const bf16_t* row = za + (size_t)t * ZAW;
                rq[j] = gld<unsigned>(row + qcol); rl[j] = gld<unsigned>(row + lcol); rv[j] = gld<unsigned>(row + vcol);
            }
        }
        if (ci > 0) {
#pragma unroll
            for (int nt = 0; nt < 2; ++nt) { const int sp = 32 * (ci - 1) + 16 * nt + fr, tp = dir ? 4095 - sp : sp; gst<u32x2>(od + (size_t)tp * 512 + Vs + 4 * fq, po[nt]); }
        }
        float lf0[4], lf1[4], p0[4], p1[4];
        float a0 = 0.f, a1 = 0.f;
#pragma unroll
        for (int j = 0; j < 4; ++j) { lf0[j] = bf_lo(cl[j]); lf1[j] = bf_hi(cl[j]); a0 += lf0[j]; a1 += lf1[j]; p0[j] = a0; p1[j] = a1; }
        float off0 = 0.f, off1 = 0.f, tot0 = 0.f, tot1 = 0.f;
#pragma unroll
        for (int ww = 0; ww < 8; ++ww) { const f32x2 g = *(const f32x2*)(GT + ww * 128 + 2 * lane); if (ww < w) { off0 += g[0]; off1 += g[1]; } tot0 += g[0]; tot1 += g[1]; }
        float kk0[4], kk1[4];
        {
            float f0[4], f1[4];
#pragma unroll
            for (int j = 0; j < 4; ++j) { f0[j] = __expf(lf0[j]); f1[j] = __expf(lf1[j]); }
            float eb0 = __expf(off0), eb1 = __expf(off1);
            const float ci0 = __expf(fminf(-tot0, 80.f)), ci1 = __expf(fminf(-tot1, 80.f));
            float ek0[4], ek1[4];
            ek0[3] = __expf(tot0 - (off0 + p0[3])); ek1[3] = __expf(tot1 - (off1 + p1[3]));
#pragma unroll
            for (int j = 2; j >= 0; --j) { ek0[j] = ek0[j + 1] * f0[j + 1]; ek1[j] = ek1[j + 1] * f1[j + 1]; }
#pragma unroll
            for (int j = 0; j < 4; ++j) {
                const int tau = 4 * w + j;
                eb0 *= f0[j]; eb1 *= f1[j];
                const float q0 = bf_lo(cq[j]), q1 = bf_hi(cq[j]);
                kk0[j] = (1.0f - f0[j]) * ek0[j]; kk1[j] = (1.0f - f1[j]) * ek1[j];
                *(unsigned*)(QP + tau * 136 + 2 * lane) = pk2(q0 * eb0, q1 * eb1);
                *(unsigned*)(KT + tau * 136 + 2 * lane) = pk2(kk0[j] * ci0, kk1[j] * ci1);
            }
        }
        { u32x2 o;
          o.x = pk2(kk0[0], kk0[1]); o.y = pk2(kk0[2], kk0[3]); *(u32x2*)(KC + (2 * lane) * 40 + 4 * w) = o;
          o.x = pk2(kk1[0], kk1[1]); o.y = pk2(kk1[2], kk1[3]); *(u32x2*)(KC + (2 * lane + 1) * 40 + 4 * w) = o;
          o.x = (cv[0] & 0xffffu) | (cv[1] << 16); o.y = (cv[2] & 0xffffu) | (cv[3] << 16); *(u32x2*)(VC + (2 * lane) * 40 + 4 * w) = o;
          o.x = (cv[0] >> 16) | (cv[1] & 0xffff0000u); o.y = (cv[2] >> 16) | (cv[3] & 0xffff0000u); *(u32x2*)(VC + (2 * lane + 1) * 40 + 4 * w) = o; }
        if (w == 0) *(f32x2*)(DD + 2 * lane) = (f32x2){__expf(tot0), __expf(tot1)};
        __syncthreads();
        if (w < 3) {
            const int st_ = (w == 2) ? 1 : 0, ct_ = (w == 0) ? 0 : 1;
            f32x4 at = {0.f, 0.f, 0.f, 0.f};
#pragma unroll
            for (int kb = 0; kb < 4; ++kb) {
                const bf16x8 A = *(const bf16x8*)(KT + (16 * st_ + fr) * 136 + 32 * kb + 8 * fq);
                const bf16x8 B = *(const bf16x8*)(QP + (16 * ct_ + fr) * 136 + 32 * kb + 8 * fq);
                at = mfma16(A, B, at);
            }
            const int c = 16 * ct_ + fr, s0 = 16 * st_ + 4 * fq;
            u32x2 o;
            o.x = pk2(s0 + 0 <= c ? at[0] : 0.f, s0 + 1 <= c ? at[1] : 0.f); o.y = pk2(s0 + 2 <= c ? at[2] : 0.f, s0 + 3 <= c ? at[3] : 0.f);
            *(u32x2*)(ATT + c * 40 + s0) = o;
        }
        f32x4 o2[2] = {(f32x4){0.f, 0.f, 0.f, 0.f}, (f32x4){0.f, 0.f, 0.f, 0.f}};
#pragma unroll
        for (int kb = 0; kb < 4; ++kb) {
            const bf16x8 A = mk8u(pk2(S[2 * kb][0], S[2 * kb][1]), pk2(S[2 * kb][2], S[2 * kb][3]), pk2(S[2 * kb + 1][0], S[2 * kb + 1][1]), pk2(S[2 * kb + 1][2], S[2 * kb + 1][3]));
#pragma unroll
            for (int nt = 0; nt < 2; ++nt) {
                const bf16_t* qp = QP + (16 * nt + fr) * 136 + 32 * kb + 4 * fq;
                const bf16x8 B = mk8(*(const u32x2*)qp, *(const u32x2*)(qp + 16));
                o2[nt] = mfma16(A, B, o2[nt]);
            }
        }
        if (ci + 1 < 128) {
            float n0 = 0.f, n1 = 0.f;
#pragma unroll
            for (int j = 0; j < 4; ++j) { n0 += bf_lo(rl[j]); n1 += bf_hi(rl[j]); }
            *(f32x2*)(GT + w * 128 + 2 * lane) = (f32x2){n0, n1};
        }
        __syncthreads();
#pragma unroll
        for (int j = 0; j < 4; ++j) asm volatile("" :: "v"(rq[j]), "v"(rv[j]));
        const bf16x8 vfrag = *(const bf16x8*)(VC + (Vs + fr) * 40 + 8 * fq);
#pragma unroll
        for (int nt = 0; nt < 2; ++nt) {
            const bf16x8 B = *(const bf16x8*)(ATT + (16 * nt + fr) * 40 + 8 * fq);
            o2[nt] = mfma16(vfrag, B, o2[nt]);
            po[nt].x = pk2(o2[nt][0], o2[nt][1]); po[nt].y = pk2(o2[nt][2], o2[nt][3]);
        }
#pragma unroll
        for (int kt = 0; kt < 8; ++kt) {
            const f32x4 d4 = *(const f32x4*)(DD + 16 * kt + 4 * fq);
            const bf16x8 A = *(const bf16x8*)(KC + (16 * kt + fr) * 40 + 8 * fq);
            S[kt] = mfma16(A, vfrag, S[kt] * d4);
        }
    }
#pragma unroll
    for (int nt = 0; nt < 2; ++nt) { const int sp = 32 * 127 + 16 * nt + fr, tp = dir ? 4095 - sp : sp; gst<u32x2>(od + (size_t)tp * 512 + Vs + 4 * fq, po[nt]); }
    __syncthreads();
}


#define XB_TMO      128
#define XB_XCNT(j)  (256  + 64 * (j))
#define XB_XSUB(j)  (1280 + 64 * (j))
#define XB_XGEN(j)  (2304 + 64 * (j))
#define XB_TOP      3328
#define XB_TOPGEN   3392
#define XCD_BAR_WORDS 3456
#define XB_SPIN_CAP (1u << 18)
__device__ __forceinline__ unsigned xb_ld(unsigned* p)              { return __hip_atomic_load(p, __ATOMIC_RELAXED, __HIP_MEMORY_SCOPE_AGENT); }
__device__ __forceinline__ unsigned xb_add(unsigned* p, unsigned v) { return __hip_atomic_fetch_add(p, v, __ATOMIC_RELAXED, __HIP_MEMORY_SCOPE_AGENT); }
__device__ __forceinline__ unsigned xb_xcc_id() { return (unsigned)__builtin_amdgcn_s_getreg((3 << 11) | 20) & 0xFu; }
#define XB_SPIN(cond, bar) do { unsigned _sp = 0; while (cond) { __builtin_amdgcn_s_sleep(1); \
    if ((++_sp & 255u) == 0u) { if (xb_ld(&(bar)[XB_TMO])) break; if (_sp > XB_SPIN_CAP) { atomicAdd(&(bar)[XB_TMO], 1u); break; } } } } while (0)
struct XcdBarrier { unsigned* bar; unsigned x; volatile LAS unsigned* st; };
__device__ __forceinline__ XcdBarrier xcd_barrier_post(unsigned* bar, volatile LAS unsigned* st) {
    XcdBarrier b; b.bar = bar; b.x = xb_xcc_id(); b.st = st;
    if (threadIdx.x == 0) (void)xb_add(&bar[XB_XCNT(b.x)], 1u);
    return b;
}
__device__ __forceinline__ void xcd_barrier_complete(unsigned* bar, unsigned x, unsigned& nloc, unsigned& nx) {
    const unsigned G = gridDim.x * gridDim.y * gridDim.z;
    unsigned sum, cnt, mine, sp = 0u;
    for (;;) {
        sum = 0u; cnt = 0u; mine = 0u;
#pragma unroll
        for (unsigned j = 0; j < 16; ++j) { const unsigned c = xb_ld(&bar[XB_XCNT(j)]); sum += c; cnt += (c > 0u) ? 1u : 0u; mine = (j == x) ? c : mine; }
        if (sum == G) break;
        __builtin_amdgcn_s_sleep(1);
        if ((++sp & 255u) == 0u) { if (xb_ld(&bar[XB_TMO])) break; if (sp > XB_SPIN_CAP) { atomicAdd(&bar[XB_TMO], 1u); break; } }
    }
    nloc = mine > 0u ? mine : 1u; nx = cnt > 0u ? cnt : 1u;
}
__device__ __forceinline__ void gbar(const XcdBarrier& b) {
    asm volatile("s_waitcnt vmcnt(0) lgkmcnt(0)" ::: "memory");
    __syncthreads();
    if (otid() == 0) {
        unsigned* bar = b.bar;
        __builtin_amdgcn_s_waitcnt(0);
        unsigned nloc = b.st[0], nx = b.st[1];
        if (nloc == 0u) { xcd_barrier_complete(bar, b.x, nloc, nx); b.st[0] = nloc; b.st[1] = nx; }
        const unsigned old = xb_add(&bar[XB_XSUB(b.x)], 1u);
        const unsigned gen = old / nloc;
        if (old + 1u == (gen + 1u) * nloc) {
            __builtin_amdgcn_fence(__ATOMIC_RELEASE, "agent");
            asm volatile("s_waitcnt vmcnt(0)" ::: "memory");
            const unsigned og = xb_add(&bar[XB_TOP], 1u);
            const unsigned tg = og / nx;
            if (og + 1u == (tg + 1u) * nx) xb_add(&bar[XB_TOPGEN], 1u);
            else XB_SPIN(xb_ld(&bar[XB_TOPGEN]) == tg, bar);
            __builtin_amdgcn_fence(__ATOMIC_ACQUIRE, "agent");
            xb_add(&bar[XB_XGEN(b.x)], 1u);
            asm volatile("s_waitcnt vmcnt(0)" ::: "memory");
        } else {
            XB_SPIN(xb_ld(&bar[XB_XGEN(b.x)]) == gen, bar);
            __builtin_amdgcn_fence(__ATOMIC_ACQUIRE, "agent");
            asm volatile("s_waitcnt vmcnt(0)" ::: "memory");
        }
    }
    __syncthreads();
}

#ifndef STOP_AFTER
#define STOP_AFTER 0
#endif
__device__ __forceinline__ void dump_bf16(float* out, const bf16_t* src, size_t n, int nsrc) {
    for (size_t i = (size_t)blockIdx.x * 512 + threadIdx.x; i < (size_t)MTOK * DM; i += (size_t)gridDim.x * 512) {
        float a = 0.f;
        for (int k = 0; k < nsrc; ++k) { const size_t j = (i + (size_t)k * MTOK * DM) % n; a += __uint_as_float(((unsigned)src[j]) << 16); }
        out[i] = a;
    }
}
#define STOP(code, src, n, nsrc) do { if (STOP_AFTER == (code)) { if ((n) > 0) dump_bf16(p.out, (src), (n), (nsrc)); return; } } while (0)

__global__ void __launch_bounds__(512, 2) fwd_megakernel(Params p0) {
    extern __shared__ __attribute__((aligned(16))) unsigned char shm[];
    cg::grid_group grid = cg::this_grid();
    LAS unsigned char* lds = (LAS unsigned char*)shm;
    const int G = gridDim.x;
    pg8::StaticOrder S;
    unsigned char* const ws = p0.ws;
    const float* mod = (const float*)(ws + OFF_MOD);
    bf16_t* hb = (bf16_t*)(ws + OFF_HB); bf16_t* zb = (bf16_t*)(ws + OFF_ZB);

    volatile LAS unsigned* xst = (volatile LAS unsigned*)(lds + 131072);
    if (threadIdx.x == 0) { xst[0] = 0u; xst[1] = 0u; }
    __syncthreads();
    const XcdBarrier xb = xcd_barrier_post((unsigned*)(p0.ws + OFF_BAR), xst);
    if (p0.ws == nullptr) grid.sync();
    if (blockIdx.x == 0 && threadIdx.x == 0) { Params* d = (Params*)(p0.ws + OFF_PRM); d->x = p0.x; d->c = p0.c; d->ada_w = p0.ada_w; d->ada_b = p0.ada_b; d->nmg = p0.nmg; d->nfg = p0.nfg; d->ewin = p0.ewin; d->ewout = p0.ewout; d->lblog = p0.lblog; d->hng = p0.hng; d->rpb = p0.rpb; d->owin = p0.owin; d->owout = p0.owout; d->poolw = p0.poolw; d->pools = p0.pools; d->wup = p0.wup; d->convw = p0.convw; d->convb = p0.convb; d->wdn = p0.wdn; d->fng = p0.fng; d->out = p0.out; d->ws = p0.ws; }
    prep_mod(p0, shm);
#ifdef DUP_PREP
    prep_mod(p0, shm); prep_mod(p0, shm);
#endif
    convert_layer(p0, 0, shm, 0, gridDim.x);
    gbar(xb);
    const Params& p = *(const Params*)(p0.ws + OFF_PRM);
    for (int l = 0; l < DEPTH; ++l) {
        const int e = l >> 1, odd = l & 1;
        const float* modl = mod + (size_t)l * NB * 6144;
        const float* xcur = (l == 0) ? p.x : p.out;
        unsigned char* const wb = ws + (size_t)(l % 3) * SZ_WSET;
        bf16_t* win = (bf16_t*)(wb + OFF_WIN); bf16_t* wout = (bf16_t*)(wb + OFF_WOUT); bf16_t* wup = (bf16_t*)(wb + OFF_WUP); bf16_t* wdn = (bf16_t*)(wb + OFF_WDN);
        if (l > 0 && G < 128) convert_layer(p, l, shm, 0, G);
        norm_rows(xcur, p.nmg + l * DM, modl, 0, DM, hb);
        gbar(xb);
        STOP(10 * l + 1, hb, (size_t)MTOK * DM, 1);
#ifdef DUP_INPROJ
        for (int rep3 = 0; rep3 < 2; ++rep3)
#endif
        if (!odd) {
            { pg8::Gemm g{hb, win, MTOK, 3584, 1024, 1024, 1024}; S.init(g.M, g.N, G, obid());
              EpiEvenIn E{zb + ZE_ZA / 2, zb + ZE_QN / 2, zb + ZE_KN / 2, (const float*)(ws + OFF_LB) + e * 512};
              pg8::gemm_phase(lds, g, S, E); }
            { pg8::Gemm g{win + (size_t)3584 * 1024, hb, 512, MTOK, 1024, 1024, 1024}; S.init(g.M, g.N, G, obid());
              EpiEvenV E{zb + ZE_VN / 2};
              pg8::gemm_phase(lds, g, S, E); }
        } else {
            { pg8::Gemm g{hb, win, MTOK, 3584, 1024, 1024, 1024}; S.init(g.M, g.N, G, obid());
              EpiOddIn E{zb + ZO_QC / 2, zb + ZO_KC / 2, zb + ZO_PU / 2};
              pg8::gemm_phase(lds, g, S, E); }
            { pg8::Gemm g{win + (size_t)3584 * 1024, hb, 1536, MTOK, 1024, 1024, 1024}; S.init(g.M, g.N, G, obid());
              EpiOddV E{zb + ZO_VC / 2};
              pg8::gemm_phase(lds, g, S, E); }
        }
        gbar(xb);
        STOP(10 * l + 2, zb, (size_t)MTOK * 5120, 5);
        const int tid_ = otid(), lane = tid_ & 63, wave = tid_ >> 6;
        if (!odd) {
#ifdef DUP_MIX_EVEN
            for (int rep = 0; rep < 2; ++rep) {
#endif
#ifndef SKIP_HGRN
            for (int ch = obid(); ch < 64; ch += G) hgrn_chain(p, ch, shm);
#endif
#ifdef DUP_HGRN
            for (int ch = obid(); ch < 64; ch += G) hgrn_chain(p, ch, shm);
#endif
            { const int nab = (G >= 128) ? G - 64 : G, na0 = (G >= 128) ? obid() - 64 : obid();
#ifndef SKIP_NA
              if (na0 >= 0) for (int tk = na0 * 8 + wave; tk < 16384; tk += nab * 8) na_task(p, e, tk, lane);
#ifdef DUP_NA
              if (na0 >= 0) for (int tk = na0 * 8 + wave; tk < 16384; tk += nab * 8) na_task(p, e, tk, lane);
              if (na0 >= 0) for (int tk = na0 * 8 + wave; tk < 16384; tk += nab * 8) na_task(p, e, tk, lane);
#endif
#endif
            }
#ifdef DUP_MIX_EVEN
            }
#endif
            if (G >= 128 && obid() >= 64) {
                convert_layer(p, l + 1, shm, 64, G - 64);
                if (l == 0) convert_layer(p, 2, shm, 64, G - 64);
            }
            gbar(xb);
            hgrn_combine(p, e);
        } else {
#ifdef DUP_MIX_ODD
            for (int rep = 0; rep < 2; ++rep) {
#endif
#ifdef DUP_DIL
            for (int rep2 = 0; rep2 < 2; ++rep2)
#endif
            dil_block(p, shm);
#ifdef DUP_POOL
            for (int rep2 = 0; rep2 < 3; ++rep2)
#endif
            pool_pass(p, 0, G);
#ifdef DUP_MIX_ODD
            }
#endif
        }
        gbar(xb);
        STOP(10 * l + 3, hb, (size_t)MTOK * DM, 1);
        { pg8::Gemm g{hb, wout, MTOK, 1024, 1024, 1024, 1024}; S.init(g.M, g.N, G, obid());
          EpiResid E{xcur, p.out, modl + 2 * DM};
          pg8::gemm_phase(lds, g, S, E); }
        gbar(xb);
        STOP(10 * l + 4, hb, (size_t)0, 0);
#ifdef DUP_NORM
        for (int rep = 0; rep < 3; ++rep)
#endif
        norm_rows(p.out, p.nfg + l * DM, modl, 3 * DM, 4 * DM, hb);
        gbar(xb);
#ifdef DUP_UP
        for (int rep4 = 0; rep4 < 2; ++rep4)
#endif
        { pg8::Gemm g{hb, wup, MTOK, 5632, 1024, 1024, 1024}; S.init(g.M, g.N, G, obid());
          EpiFfnUp E{zb + ZF_U / 2, (float*)(ws + OFF_ZB + ZF_HG), (float*)(ws + OFF_ZB + ZF_HV), p.convw + (size_t)l * 3 * DFF, p.convb + (size_t)l * DFF};
          pg8::gemm_phase(lds, g, S, E); }
        gbar(xb);
        ffn_fix(p, l);
        gbar(xb);
        { pg8::Gemm g{zb + ZF_U / 2, wdn, MTOK, 1024, 2816, 2816, 2816}; S.init(g.M, g.N, G, obid());
          EpiResid E{p.out, p.out, modl + 5 * DM};
          pg8::gemm_phase(lds, g, S, E); }
        gbar(xb);
    }
    final_norm(p.out, p.fng);
}

extern "C" void kernel_launch(void* const* d_in, const int* in_sizes, int n_in, void* d_out, int out_size, void* d_ws, size_t ws_size, hipStream_t stream) {
    constexpr size_t kLds = 131072 + 64;
    static int grid_blocks = 0;
    if (!grid_blocks) {
        int dev = 0, cus = 0, per_cu = 0;
        (void)hipGetDevice(&dev);
        (void)hipDeviceGetAttribute(&cus, hipDeviceAttributeMultiprocessorCount, dev);
        (void)hipFuncSetAttribute((const void*)fwd_megakernel, hipFuncAttributeMaxDynamicSharedMemorySize, (int)kLds);
        (void)hipOccupancyMaxActiveBlocksPerMultiprocessor(&per_cu, (const void*)fwd_megakernel, 512, kLds);
        if (per_cu < 1) per_cu = 1;
        grid_blocks = cus * per_cu;
        if (ws_size < WS_END || n_in != 20) fprintf(stderr, "kernel_launch: workspace %zu < %zu or n_in %d != 20\n", ws_size, (size_t)WS_END, n_in);
    }
    Params p{};
    const float** pp = (const float**)&p;
    for (int i = 0; i < 20; ++i) pp[i] = (const float*)d_in[i];
    p.out = (float*)d_out; p.ws = (unsigned char*)d_ws;
    (void)hipMemsetAsync((unsigned char*)d_ws + OFF_BAR, 0, 16384, stream);
    void* args[] = {&p};
    hipError_t er = hipLaunchCooperativeKernel((const void*)fwd_megakernel, dim3(grid_blocks), dim3(512), args, kLds, stream);
    if (er != hipSuccess) fprintf(stderr, "cooperative launch failed: %s (grid %d)\n", hipGetErrorString(er), grid_blocks);
}
```

```cpp
#include <hip/hip_runtime.h>
#include <hip/hip_cooperative_groups.h>
#include <cstdio>
#include <cstdint>
namespace cg = cooperative_groups;

#define LAS __attribute__((address_space(3)))
typedef unsigned short bf16_t;
typedef short bf16x8 __attribute__((ext_vector_type(8)));
typedef float f32x4 __attribute__((ext_vector_type(4)));
typedef float f32x2 __attribute__((ext_vector_type(2)));
typedef unsigned u32x4 __attribute__((ext_vector_type(4)));
typedef unsigned u32x2 __attribute__((ext_vector_type(2)));

constexpr int NB = 8, SEQ = 4096, DM = 1024, MTOK = NB * SEQ, DFF = 2816, DEPTH = 4;
constexpr int ZAW = 2560;
constexpr float RMS_EPS = 1e-6f;
constexpr float NEG_BIG = -1e30f;
constexpr float LOG2E = 1.4426950408889634f;

constexpr size_t SZ_MOD = (size_t)DEPTH * NB * 6 * DM * 4;
constexpr size_t OFF_MOD = 0;
constexpr size_t OFF_LB = OFF_MOD + SZ_MOD;
constexpr size_t OFF_PRM = OFF_LB + 4096;
constexpr size_t OFF_BAR = OFF_PRM + 4096;
constexpr size_t OFF_WIN = OFF_BAR + 16384;
constexpr size_t OFF_WOUT = OFF_WIN + (size_t)5120 * 1024 * 2;
constexpr size_t OFF_WUP = OFF_WOUT + (size_t)1024 * 1024 * 2;
constexpr size_t OFF_WDN = OFF_WUP + (size_t)5632 * 1024 * 2;
constexpr size_t SZ_WSET = OFF_WDN + (size_t)1024 * 2816 * 2 - OFF_WIN;
constexpr size_t OFF_HB = OFF_WIN + 3 * SZ_WSET;
constexpr size_t OFF_ZB = OFF_HB + (size_t)MTOK * DM * 2;
constexpr size_t SZ_ZB = (size_t)MTOK * 5632 * 2;
constexpr size_t WS_END = OFF_ZB + SZ_ZB;
constexpr size_t ZE_ZA = 0;
constexpr size_t ZE_QN = ZE_ZA + (size_t)MTOK * ZAW * 2;
constexpr size_t ZE_KN = ZE_QN + (size_t)MTOK * 512 * 2;
constexpr size_t ZE_VN = ZE_KN + (size_t)MTOK * 512 * 2;
constexpr size_t ZE_OF = ZE_VN + (size_t)MTOK * 512 * 2;
constexpr size_t ZE_OB = ZE_OF + (size_t)MTOK * 512 * 2;
static_assert(ZE_OB + (size_t)MTOK * 512 * 2 <= SZ_ZB, "even layout");
constexpr size_t ZO_QC = 0;
constexpr size_t ZO_KC = ZO_QC + (size_t)MTOK * 1536 * 2;
constexpr size_t ZO_VC = ZO_KC + (size_t)MTOK * 1536 * 2;
constexpr size_t ZO_PU = ZO_VC + (size_t)MTOK * 1536 * 2;
static_assert(ZO_PU + (size_t)MTOK * 512 * 2 <= SZ_ZB, "odd layout");

constexpr size_t ZF_U = 0;
constexpr size_t ZF_HG = ZF_U + (size_t)MTOK * DFF * 2;
constexpr size_t ZF_HV = ZF_HG + (size_t)512 * 4 * DFF * 4;
static_assert(ZF_HV + (size_t)512 * 2 * DFF * 4 <= SZ_ZB, "ffn layout");

struct Params {
    const float *x, *c, *ada_w, *ada_b, *nmg, *nfg, *ewin, *ewout, *lblog, *hng, *rpb, *owin, *owout, *poolw, *pools, *wup, *convw, *convb, *wdn, *fng;
    float* out; unsigned char* ws;
};

__device__ __forceinline__ int obid() { int t = blockIdx.x; asm volatile("" : "+s"(t)); return t; }
__device__ __forceinline__ int otid() { int t = threadIdx.x; asm volatile("" : "+v"(t)); return t; }
typedef __bf16 bf16x2_t __attribute__((ext_vector_type(2)));
#define GAS __attribute__((address_space(1)))
template <class T> __device__ __forceinline__ T gld(const void* p) { return *(const GAS T*)p; }
template <class T> __device__ __forceinline__ void gst(void* p, T v) { *(GAS T*)p = v; }
__device__ __forceinline__ float shx(float v, int m) { return __int_as_float(__builtin_amdgcn_ds_bpermute((otid() ^ m) << 2, __float_as_int(v))); }
__device__ __forceinline__ unsigned pk2(float lo, float hi) { f32x2 v = {lo, hi}; bf16x2_t b = __builtin_convertvector(v, bf16x2_t); return __builtin_bit_cast(unsigned, b); }
__device__ __forceinline__ float bf_lo(unsigned u) { return __uint_as_float(u << 16); }
__device__ __forceinline__ float bf_hi(unsigned u) { return __uint_as_float(u & 0xffff0000u); }
__device__ __forceinline__ float sigmoidf_(float v) { return __builtin_amdgcn_rcpf(1.0f + __expf(-v)); }
__device__ __forceinline__ float siluf_(float v) { return v * __builtin_amdgcn_rcpf(1.0f + __expf(-v)); }
__device__ __forceinline__ f32x4 mfma16(bf16x8 a, bf16x8 b, f32x4 c) { return __builtin_amdgcn_mfma_f32_16x16x32_bf16(a, b, c, 0, 0, 0); }
__device__ __forceinline__ bf16x8 mk8(u32x2 lo, u32x2 hi) { u32x4 t; t.x = lo.x; t.y = lo.y; t.z = hi.x; t.w = hi.y; return __builtin_bit_cast(bf16x8, t); }
__device__ __forceinline__ bf16x8 mk8u(unsigned a, unsigned b, unsigned c, unsigned d) { u32x4 t; t.x = a; t.y = b; t.z = c; t.w = d; return __builtin_bit_cast(bf16x8, t); }
__device__ __forceinline__ void unpack8(u32x4 r, float (&v)[8]) { v[0] = bf_lo(r.x); v[1] = bf_hi(r.x); v[2] = bf_lo(r.y); v[3] = bf_hi(r.y); v[4] = bf_lo(r.z); v[5] = bf_hi(r.z); v[6] = bf_lo(r.w); v[7] = bf_hi(r.w); }
__device__ __forceinline__ u32x4 pack8(const float (&v)[8]) { u32x4 o; o.x = pk2(v[0], v[1]); o.y = pk2(v[2], v[3]); o.z = pk2(v[4], v[5]); o.w = pk2(v[6], v[7]); return o; }

namespace pg8 {
constexpr int BM = 256, BK = 64, HALF = 128, HTB = HALF * BK * 2, STAGE_BYTES = 8 * HTB, NXCD = 8, WGM = 8;
__host__ __device__ __forceinline__ int lds_byte(int r, int c) { const int st = (r >> 4) * 2 + (c >> 5), rr = r & 15, cc = c & 31, ob = rr * 64 + cc * 2; return st * 1024 + (ob ^ (((ob >> 9) & 1) << 5)); }
__host__ __device__ __forceinline__ void stage_rc(int b, int& R, int& C) { const int st = b / 1024, sb = b % 1024, swz = sb ^ (((sb >> 9) & 1) << 5); R = (st >> 1) * 16 + swz / 64; C = (st & 1) * 32 + (swz % 64) / 2; }
__host__ __device__ __forceinline__ int perm32(int rho) { const int n = rho >> 4, i = rho & 15; return 8 * (i >> 2) + 4 * n + (i & 3); }

struct Unit { int pm, pn; };
struct Gemm { const bf16_t* A; const bf16_t* Bt; int M, N, K, lda, ldb; };

struct StaticOrder {
    int nM, nN, nwg, G, c;
    __device__ void init(int M, int N, int G_, int c_) { nM = M / BM; nN = N / BM; nwg = nM * nN; G = G_; c = c_; }
    __device__ bool next(int i, Unit& u) const {
        const int L = i * G + c; if (L >= nwg) return false;
        int wgid = L; { const int q = nwg / NXCD, r = nwg % NXCD, xcd = wgid % NXCD, off = wgid / NXCD; wgid = (xcd < r ? xcd * (q + 1) : r * (q + 1) + (xcd - r) * q) + off; }
        const int nig = WGM * nN, gid = wgid / nig, fm = gid * WGM, gsz = (nM - fm) < WGM ? (nM - fm) : WGM;
        u.pm = fm + ((wgid % nig) % gsz); u.pn = (wgid % nig) / gsz; return true;
    }
};

template <class Epi, bool ALIGN_EPI = true, bool SP2 = true>
__device__ __forceinline__ void gemm_phase(LAS unsigned char* lds, const Gemm g, const StaticOrder& S, const Epi& E) {
    const int tid = otid(), wid = __builtin_amdgcn_readfirstlane(tid >> 6), lane = tid & 63, wr = wid >> 2, wc = wid & 3, fr = lane & 15, fq = lane >> 4;
    const int K = g.K, nt = K / BK;
    unsigned voffA[2], voffB[2];
#pragma unroll
    for (int i = 0; i < 2; ++i) { int R, C; stage_rc(tid * 16 + i * 8192, R, C); const int Rb = Epi::PERM ? ((R & ~31) + perm32(R & 31)) : R;
        voffA[i] = (unsigned)(R * g.lda + C) * 2u; voffB[i] = (unsigned)(Rb * g.ldb + C) * 2u; }
    const size_t kstep = (size_t)(BK * 2);
    const size_t hstepA = (size_t)HALF * g.lda * 2, hstepB = (size_t)HALF * g.ldb * 2;
    const size_t tstepA = 2 * hstepA, tstepB = 2 * hstepB;
    const unsigned ldsw = (unsigned)wid * 1024u;
    const int aoff = lds_byte(wr * 64 + fr, fq * 8), boff = lds_byte(wc * 32 + fr, fq * 8);
#define PG8_SA(b, h) (((b) * 2 + (h)) * HTB)
#define PG8_SB(b, h) ((4 + (b) * 2 + (h)) * HTB)
#define PG8_STAGE(bufoff, gbase, voff) do { _Pragma("unroll") for (int _i = 0; _i < 2; ++_i) \
        __builtin_amdgcn_global_load_lds((const unsigned*)((const char*)(gbase) + (voff)[_i]), (LAS unsigned*)(lds + (bufoff) + ldsw + _i * 8192), 16, 0, 0); } while (0)
#define PG8_LDA(dst, b, h) do { _Pragma("unroll") for (int m = 0; m < 4; ++m) _Pragma("unroll") for (int k = 0; k < 2; ++k) dst[m][k] = *(const LAS bf16x8*)(lds + PG8_SA(b, h) + aoff + m * 2048 + k * 1024); } while (0)
#define PG8_LDB(dst, b, h) do { _Pragma("unroll") for (int n = 0; n < 2; ++n) _Pragma("unroll") for (int k = 0; k < 2; ++k) dst[n][k] = *(const LAS bf16x8*)(lds + PG8_SB(b, h) + boff + n * 2048 + k * 1024); } while (0)
#define PG8_MMA(ai, bj, At, Bt) do { __builtin_amdgcn_s_setprio(1); _Pragma("unroll") for (int m = 0; m < 4; ++m) _Pragma("unroll") for (int n = 0; n < 2; ++n) _Pragma("unroll") for (int k = 0; k < 2; ++k) \
        acc[ai][bj][m][n] = __builtin_amdgcn_mfma_f32_16x16x32_bf16(Bt[n][k], At[m][k], acc[ai][bj][m][n], 0, 0, 0); __builtin_amdgcn_s_setprio(0); } while (0)
#define PG8_WAIT_V(n) asm volatile("s_waitcnt vmcnt(" #n ")" ::: "memory")
#define PG8_WAIT_L(n) asm volatile("s_waitcnt lgkmcnt(" #n ")" ::: "memory")
#define PG8_BAR __builtin_amdgcn_s_barrier()
#define PG8_SCHED __builtin_amdgcn_sched_barrier(0)
    Unit cur, nxt; int ui = 0;
    if (!S.next(0, cur)) return;
    f32x4 acc[2][2][4][2];
#pragma unroll
    for (int a = 0; a < 2; ++a)
#pragma unroll
        for (int b = 0; b < 2; ++b)
#pragma unroll
            for (int m = 0; m < 4; ++m)
#pragma unroll
                for (int n = 0; n < 2; ++n) acc[a][b][m][n] = (f32x4){0.f, 0.f, 0.f, 0.f};
    bf16x8 At[4][2], B0[2][2], B1[2][2];
    const char* cA = (const char*)g.A + (size_t)cur.pm * tstepA; const char* cB = (const char*)g.Bt + (size_t)cur.pn * tstepB;
    if constexpr (SP2) {
        PG8_STAGE(PG8_SB(0, 0), cB, voffB); PG8_STAGE(PG8_SB(0, 1), cB + hstepB, voffB); PG8_STAGE(PG8_SA(0, 0), cA, voffA); PG8_STAGE(PG8_SA(0, 1), cA + hstepA, voffA);
        if (wr == 1) PG8_BAR;
        PG8_WAIT_V(2); PG8_BAR;
        PG8_STAGE(PG8_SB(1, 0), cB + kstep, voffB); PG8_STAGE(PG8_SA(1, 0), cA + kstep, voffA); PG8_STAGE(PG8_SB(1, 1), cB + hstepB + kstep, voffB);
        PG8_WAIT_V(6); PG8_BAR;
    } else {
    PG8_STAGE(PG8_SB(0, 0), cB, voffB); PG8_STAGE(PG8_SA(0, 0), cA, voffA); PG8_STAGE(PG8_SB(0, 1), cB + hstepB, voffB); PG8_STAGE(PG8_SA(0, 1), cA + hstepA, voffA);
    if (wr == 1) PG8_BAR;
    PG8_WAIT_V(4); PG8_BAR;
    PG8_STAGE(PG8_SB(1, 0), cB + kstep, voffB); PG8_STAGE(PG8_SA(1, 0), cA + kstep, voffA); PG8_STAGE(PG8_SB(1, 1), cB + hstepB + kstep, voffB);
    PG8_WAIT_V(6); PG8_BAR;
    }
    for (;;) {
        const bool has_next = S.next(ui + 1, nxt);
        const char* nA = has_next ? (const char*)g.A + (size_t)nxt.pm * tstepA : cA; const char* nB = has_next ? (const char*)g.Bt + (size_t)nxt.pn * tstepB : cB;
        for (int t = 0; t < nt; t += 2) {
            const bool last = (t == nt - 2);
            const char* a1 = cA + (size_t)(t + 1) * kstep;
            const char* a2 = last ? nA : cA + (size_t)(t + 2) * kstep; const char* b2 = last ? nB : cB + (size_t)(t + 2) * kstep;
            const char* a3 = a2 + kstep; const char* b3 = b2 + kstep;
            if constexpr (SP2) {
            PG8_LDB(B0, 0, 0); PG8_LDB(B1, 0, 1); PG8_SCHED; PG8_LDA(At, 0, 0); PG8_STAGE(PG8_SA(1, 1), a1 + hstepA, voffA);
            PG8_WAIT_V(8); PG8_WAIT_L(0); PG8_BAR; PG8_MMA(0, 0, At, B0); PG8_MMA(0, 1, At, B1); PG8_BAR; PG8_SCHED;
            PG8_LDA(At, 0, 1); PG8_STAGE(PG8_SB(0, 0), b2, voffB); PG8_STAGE(PG8_SB(0, 1), b2 + hstepB, voffB); PG8_STAGE(PG8_SA(0, 0), a2, voffA);
            PG8_WAIT_V(8); PG8_WAIT_L(0); PG8_BAR; PG8_MMA(1, 0, At, B0); PG8_MMA(1, 1, At, B1); PG8_BAR; PG8_SCHED;
            PG8_LDB(B0, 1, 0); PG8_LDB(B1, 1, 1); PG8_SCHED; PG8_LDA(At, 1, 0); PG8_STAGE(PG8_SA(0, 1), a2 + hstepA, voffA);
            PG8_WAIT_V(8); PG8_WAIT_L(0); PG8_BAR; PG8_MMA(0, 0, At, B0); PG8_MMA(0, 1, At, B1); PG8_BAR; PG8_SCHED;
            PG8_LDA(At, 1, 1); PG8_STAGE(PG8_SB(1, 0), b3, voffB); PG8_STAGE(PG8_SB(1, 1), b3 + hstepB, voffB); PG8_STAGE(PG8_SA(1, 0), a3, voffA);
            PG8_WAIT_V(8); PG8_WAIT_L(0); PG8_BAR; PG8_MMA(1, 0, At, B0); PG8_MMA(1, 1, At, B1); PG8_BAR; PG8_SCHED;
            } else {
            PG8_LDB(B0, 0, 0); PG8_SCHED; PG8_LDA(At, 0, 0); PG8_STAGE(PG8_SA(1, 1), a1 + hstepA, voffA);
            PG8_WAIT_L(8); PG8_BAR; PG8_WAIT_L(0); PG8_MMA(0, 0, At, B0); PG8_BAR; PG8_SCHED;
            PG8_LDB(B1, 0, 1); PG8_STAGE(PG8_SB(0, 0), b2, voffB);
            PG8_BAR; PG8_WAIT_L(0); PG8_MMA(0, 1, At, B1); PG8_BAR;
            PG8_LDA(At, 0, 1); PG8_STAGE(PG8_SA(0, 0), a2, voffA);
            PG8_BAR; PG8_WAIT_L(0); PG8_MMA(1, 0, At, B0); PG8_BAR; PG8_SCHED;
            PG8_STAGE(PG8_SB(0, 1), b2 + hstepB, voffB);
            PG8_WAIT_V(6); PG8_BAR; PG8_MMA(1, 1, At, B1); PG8_BAR;
            PG8_LDB(B0, 1, 0); PG8_SCHED; PG8_LDA(At, 1, 0); PG8_STAGE(PG8_SA(0, 1), a2 + hstepA, voffA);
            PG8_WAIT_L(8); PG8_BAR; PG8_WAIT_L(0); PG8_MMA(0, 0, At, B0); PG8_BAR; PG8_SCHED;
            PG8_LDB(B1, 1, 1); PG8_STAGE(PG8_SB(1, 0), b3, voffB);
            PG8_BAR; PG8_WAIT_L(0); PG8_MMA(0, 1, At, B1); PG8_BAR;
            PG8_LDA(At, 1, 1); PG8_STAGE(PG8_SA(1, 0), a3, voffA);
            PG8_BAR; PG8_WAIT_L(0); PG8_MMA(1, 0, At, B0); PG8_BAR; PG8_SCHED;
            PG8_STAGE(PG8_SB(1, 1), b3 + hstepB, voffB);
            PG8_WAIT_V(6); PG8_BAR; PG8_MMA(1, 1, At, B1); PG8_BAR;
            }
        }
        if constexpr (ALIGN_EPI) { if (wr == 0) PG8_BAR; }
        E(acc, cur, wr, wc, fr, fq);
        if (!has_next) break;
#pragma unroll
        for (int a = 0; a < 2; ++a)
#pragma unroll
            for (int b = 0; b < 2; ++b)
#pragma unroll
                for (int m = 0; m < 4; ++m)
#pragma unroll
                    for (int n = 0; n < 2; ++n) acc[a][b][m][n] = (f32x4){0.f, 0.f, 0.f, 0.f};
        cur = nxt; cA = nA; cB = nB; ++ui;
        if constexpr (ALIGN_EPI) { if (wr == 1) PG8_BAR; }
    }
    PG8_WAIT_V(0);
    if constexpr (!ALIGN_EPI) { if (wr == 0) PG8_BAR; }
    PG8_BAR;
#undef PG8_SA
#undef PG8_SB
#undef PG8_STAGE
#undef PG8_LDA
#undef PG8_LDB
#undef PG8_MMA
#undef PG8_WAIT_V
#undef PG8_WAIT_L
#undef PG8_BAR
#undef PG8_SCHED
}
}
using pg8::Unit;

__device__ __forceinline__ void acc8(const f32x4 (&acc)[2][2][4][2], int ai, int bj, int m, float (&v)[8]) {
    const f32x4 a = acc[ai][bj][m][0], b = acc[ai][bj][m][1];
    v[0] = a[0]; v[1] = a[1]; v[2] = a[2]; v[3] = a[3]; v[4] = b[0]; v[5] = b[1]; v[6] = b[2]; v[7] = b[3];
}

struct EpiEvenIn {
    static constexpr bool PERM = true;
    bf16_t *za, *qn, *kn; const float* lb;
    __device__ __forceinline__ void operator()(const f32x4 (&acc)[2][2][4][2], const Unit& u, int wr, int wc, int fr, int fq) const {
        const int region = u.pn >> 1;
#pragma unroll
        for (int bj = 0; bj < 2; ++bj) {
            const int c8 = u.pn * 256 + bj * 128 + wc * 32 + 8 * fq;
            float lbv[8];
            if (region == 1 || region == 2) {
                const f32x4 l0 = gld<f32x4>(lb + (c8 & 511)), l1 = gld<f32x4>(lb + (c8 & 511) + 4);
                lbv[0] = l0[0]; lbv[1] = l0[1]; lbv[2] = l0[2]; lbv[3] = l0[3]; lbv[4] = l1[0]; lbv[5] = l1[1]; lbv[6] = l1[2]; lbv[7] = l1[3];
            } else {
#pragma unroll
                for (int i = 0; i < 8; ++i) lbv[i] = 0.f;
            }
#pragma unroll
            for (int ai = 0; ai < 2; ++ai)
#pragma unroll
                for (int m = 0; m < 4; ++m) {
                    const int r = u.pm * 256 + ai * 128 + wr * 64 + m * 16 + fr;
                    float v[8]; acc8(acc, ai, bj, m, v);
                    if (region == 0 || region == 4) {
#pragma unroll
                        for (int i = 0; i < 8; ++i) v[i] = siluf_(v[i]);
                    } else if (region == 1 || region == 2) {
#pragma unroll
                        for (int i = 0; i < 8; ++i) { const float f = fmaxf(lbv[i], 1e-12f) + (1.0f - lbv[i]) * sigmoidf_(v[i]); v[i] = __logf(f); }
                    } else if (region == 5) {
#pragma unroll
                        for (int i = 0; i < 8; ++i) v[i] *= 0.125f * LOG2E;
                    }
                    const u32x4 o = pack8(v);
                    if (region < 5) {
                        gst<u32x4>(za + (size_t)r * ZAW + c8, o);
                    } else {
                        const int cc = c8 - (region == 5 ? 2560 : 3072), hh = cc >> 6, dim = cc & 63, b = r >> 12, t = r & 4095;
                        bf16_t* dst = (region == 5 ? qn : kn) + ((size_t)((b * 8 + hh) * 4096 + t)) * 64 + dim;
                        gst<u32x4>(dst, o);
                    }
                }
        }
    }
};
struct EpiEvenV {
    static constexpr bool PERM = true;
    bf16_t* vn;
    __device__ __forceinline__ void operator()(const f32x4 (&acc)[2][2][4][2], const Unit& u, int wr, int wc, int fr, int fq) const {
#pragma unroll
        for (int ai = 0; ai < 2; ++ai)
#pragma unroll
            for (int m = 0; m < 4; ++m) {
                const int r = u.pm * 256 + ai * 128 + wr * 64 + m * 16 + fr;
#pragma unroll
                for (int bj = 0; bj < 2; ++bj) {
                    const int c8 = u.pn * 256 + bj * 128 + wc * 32 + 8 * fq;
                    const int b = c8 >> 12, t = c8 & 4095, hh = r >> 6, dv = r & 63;
                    float v[8]; acc8(acc, ai, bj, m, v);
                    const u32x4 o = pack8(v);
                    bf16_t* dst = vn + ((size_t)(b * 8 + hh) * 1024 + (t >> 2)) * 256 + dv * 4;
                    gst<u32x2>(dst, (u32x2){o.x, o.y}); gst<u32x2>(dst + 256, (u32x2){o.z, o.w});
                }
            }
    }
};
__device__ __forceinline__ int dil_pos(int gi, int t) { const int sh = 2 * gi; return ((t & ((1 << sh) - 1)) << (12 - sh)) | (t >> sh); }
struct EpiOddIn {
    static constexpr bool PERM = true;
    bf16_t *qc, *kc, *pu;
    __device__ __forceinline__ void operator()(const f32x4 (&acc)[2][2][4][2], const Unit& u, int wr, int wc, int fr, int fq) const {
        const int region = u.pn < 6 ? 0 : (u.pn < 12 ? 1 : 2);
#pragma unroll
        for (int ai = 0; ai < 2; ++ai)
#pragma unroll
            for (int m = 0; m < 4; ++m) {
                const int r = u.pm * 256 + ai * 128 + wr * 64 + m * 16 + fr, b = r >> 12, t = r & 4095;
#pragma unroll
                for (int bj = 0; bj < 2; ++bj) {
                    const int c8 = u.pn * 256 + bj * 128 + wc * 32 + 8 * fq;
                    float v[8]; acc8(acc, ai, bj, m, v);
                    if (region == 2) {
                        gst<u32x4>(pu + (size_t)r * 512 + (c8 - 3072), pack8(v));
                    } else {
                        const int cc = c8 - region * 1536, gi = cc >> 9, hh = (cc >> 6) & 7, dim = cc & 63;
                        if (region == 0) {
#pragma unroll
                            for (int i = 0; i < 8; ++i) v[i] *= 0.125f * LOG2E;
                        }
                        bf16_t* dst = (region == 0 ? qc : kc) + ((size_t)(((b * 3 + gi) * 8 + hh) * 4096 + dil_pos(gi, t))) * 64 + dim;
                        gst<u32x4>(dst, pack8(v));
                    }
                }
            }
    }
};
struct EpiOddV {
    static constexpr bool PERM = true;
    bf16_t* vc;
    __device__ __forceinline__ void operator()(const f32x4 (&acc)[2][2][4][2], const Unit& u, int wr, int wc, int fr, int fq) const {
        const int gi = u.pm >> 1;
#pragma unroll
        for (int ai = 0; ai < 2; ++ai)
#pragma unroll
            for (int m = 0; m < 4; ++m) {
                const int r = u.pm * 256 + ai * 128 + wr * 64 + m * 16 + fr, rr = r & 511;
#pragma unroll
                for (int bj = 0; bj < 2; ++bj) {
                    const int c8 = u.pn * 256 + bj * 128 + wc * 32 + 8 * fq;
                    const int b = c8 >> 12, t = c8 & 4095;
                    float v[8]; acc8(acc, ai, bj, m, v);
                    bf16_t* base = vc + ((size_t)((b * 3 + gi) * 8 + (rr >> 6))) * (4096 * 64) + (rr & 63) * 4;
                    const u32x4 o = pack8(v);
                    if (gi == 0) { bf16_t* d0 = base + (size_t)(t >> 2) * 256; gst<u32x2>(d0, (u32x2){o.x, o.y}); gst<u32x2>(d0 + 256, (u32x2){o.z, o.w}); }
                    else {
                        const unsigned w[4] = {o.x, o.y, o.z, o.w};
#pragma unroll
                        for (int i = 0; i < 8; ++i) { const int pos = dil_pos(gi, t + i); gst<bf16_t>(base + (size_t)(pos >> 2) * 256 + (pos & 3), (bf16_t)((i & 1) ? (w[i >> 1] >> 16) : (w[i >> 1] & 0xffffu))); }
                    }
                }
            }
    }
};
struct EpiResid {
    static constexpr bool PERM = false;
    const float* xin; float* xout; const float* gate;
    __device__ __forceinline__ void operator()(const f32x4 (&acc)[2][2][4][2], const Unit& u, int wr, int wc, int fr, int fq) const {
#pragma unroll
        for (int ai = 0; ai < 2; ++ai)
#pragma unroll
            for (int m = 0; m < 4; ++m) {
                const int r = u.pm * 256 + ai * 128 + wr * 64 + m * 16 + fr, b = r >> 12;
#pragma unroll
                for (int bj = 0; bj < 2; ++bj)
#pragma unroll
                    for (int n = 0; n < 2; ++n) {
                        const int c = u.pn * 256 + bj * 128 + wc * 32 + 16 * n + 4 * fq;
                        const f32x4 gv = gld<f32x4>(gate + (size_t)b * 6144 + c);
                        const f32x4 xv = gld<f32x4>(xin + (size_t)r * DM + c);
                        gst<f32x4>(xout + (size_t)r * DM + c, xv + gv * acc[ai][bj][m][n]);
                    }
            }
    }
};
struct EpiBf16 {
    static constexpr bool PERM = true;
    bf16_t* O; int ldc;
    __device__ __forceinline__ void operator()(const f32x4 (&acc)[2][2][4][2], const Unit& u, int wr, int wc, int fr, int fq) const {
#pragma unroll
        for (int ai = 0; ai < 2; ++ai)
#pragma unroll
            for (int m = 0; m < 4; ++m) {
                const int r = u.pm * 256 + ai * 128 + wr * 64 + m * 16 + fr;
#pragma unroll
                for (int bj = 0; bj < 2; ++bj) {
                    const int c8 = u.pn * 256 + bj * 128 + wc * 32 + 8 * fq;
                    float v[8]; acc8(acc, ai, bj, m, v);
                    gst<u32x4>(O + (size_t)r * ldc + c8, pack8(v));
                }
            }
    }
};

__device__ __forceinline__ float rot_up(float v) { return __int_as_float(__builtin_amdgcn_update_dpp(0, __float_as_int(v), 0x121, 0xf, 0xf, false)); }
__device__ __forceinline__ float rot_dn(float v) { return __int_as_float(__builtin_amdgcn_update_dpp(0, __float_as_int(v), 0x12F, 0xf, 0xf, false)); }
struct EpiFfnUp {
    static constexpr bool PERM = true;
    bf16_t* U; float* HG; float* HV; const float* cw; const float* cb;
    __device__ __forceinline__ void operator()(const f32x4 (&acc)[2][2][4][2], const Unit& u, int wr, int wc, int fr, int fq) const {
        const int f8 = u.pn * 128 + wc * 32 + 8 * fq;
#pragma unroll
        for (int ai = 0; ai < 2; ++ai) {
            const int span = u.pm * 4 + ai * 2 + wr, r0 = span * 64;
#pragma unroll
            for (int n = 0; n < 2; ++n) {
                unsigned pk[4][2];
#pragma unroll
                for (int jh = 0; jh < 2; ++jh) {
                    const int j0 = 2 * jh, f = f8 + 4 * n + j0;
                    const f32x2 w0 = gld<f32x2>(cw + f), w1 = gld<f32x2>(cw + DFF + f), w2 = gld<f32x2>(cw + 2 * DFF + f), bb = gld<f32x2>(cb + f);
                    float o[2][4];
#pragma unroll
                    for (int h = 0; h < 2; ++h) {
                        float G[4], ru[4], rd[4];
#pragma unroll
                        for (int m = 0; m < 4; ++m) { G[m] = acc[ai][0][m][n][j0 + h]; ru[m] = rot_up(G[m]); rd[m] = rot_dn(G[m]); }
#pragma unroll
                        for (int m = 0; m < 4; ++m) {
                            const float up = fr > 0 ? ru[m] : (m > 0 ? ru[m > 0 ? m - 1 : 0] : 0.f);
                            const float dn = fr < 15 ? rd[m] : (m < 3 ? rd[m < 3 ? m + 1 : 3] : 0.f);
                            const float gt = bb[h] + up * w0[h] + G[m] * w1[h] + dn * w2[h];
                            o[h][m] = siluf_(gt) * acc[ai][1][m][n][j0 + h];
                        }
                    }
#pragma unroll
                    for (int m = 0; m < 4; ++m) pk[m][jh] = pk2(o[0][m], o[1][m]);
                    if (fr >= 14) {
                        gst<f32x2>(HG + ((size_t)span * 4 + (fr - 14)) * DFF + f, (f32x2){acc[ai][0][3][n][j0], acc[ai][0][3][n][j0 + 1]});
                        if (fr == 15) gst<f32x2>(HV + ((size_t)span * 2 + 0) * DFF + f, (f32x2){acc[ai][1][3][n][j0], acc[ai][1][3][n][j0 + 1]});
                    } else if (fr <= 1) {
                        gst<f32x2>(HG + ((size_t)span * 4 + 2 + fr) * DFF + f, (f32x2){acc[ai][0][0][n][j0], acc[ai][0][0][n][j0 + 1]});
                        if (fr == 0) gst<f32x2>(HV + ((size_t)span * 2 + 1) * DFF + f, (f32x2){acc[ai][1][0][n][j0], acc[ai][1][0][n][j0 + 1]});
                    }
                }
#pragma unroll
                for (int m = 0; m < 4; ++m) {
                    const bool edge = (m == 0 && fr == 0) || (m == 3 && fr == 15);
                    if (!edge) { u32x2 o2; o2.x = pk[m][0]; o2.y = pk[m][1]; gst<u32x2>(U + (size_t)(r0 + 16 * m + fr) * DFF + f8 + 4 * n, o2); }
                }
            }
        }
    }
};

__device__ __forceinline__ float wave_sum64(float v) {
#pragma unroll
    for (int o = 1; o < 64; o <<= 1) v += shx(v, o);
    return v;
}

__device__ __forceinline__ void tr_store(bf16_t* dst, int ldk, int k0, int dr0, const float* lds, int tid) {
    const int n = tid >> 3, kk = (tid & 7) * 8;
    float v[8];
#pragma unroll
    for (int j = 0; j < 8; ++j) v[j] = lds[(kk + j) * 65 + n];
    *(u32x4*)(dst + (size_t)(dr0 + n) * ldk + k0 + kk) = pack8(v);
}
__device__ __forceinline__ void tr_tile(const float* src, int ldn, int k0, int sc0, bf16_t* dst, int ldk, int dr0, float* lds, int tid) {
#pragma unroll
    for (int i = 0; i < 2; ++i) {
        const int r = (tid >> 4) + 32 * i, c4 = (tid & 15) * 4;
        const f32x4 v = *(const f32x4*)(src + (size_t)(k0 + r) * ldn + sc0 + c4);
        lds[r * 65 + c4 + 0] = v[0]; lds[r * 65 + c4 + 1] = v[1]; lds[r * 65 + c4 + 2] = v[2]; lds[r * 65 + c4 + 3] = v[3];
    }
    __syncthreads();
    tr_store(dst, ldk, k0, dr0, lds, tid);
    __syncthreads();
}
__device__ __forceinline__ void fold_tile(const float* pw, const float* ps, const float* wout, int k0, int n0, bf16_t* dst, float* lds, int tid) {
    const int c4 = (tid & 15) * 4;
#pragma unroll
    for (int i = 0; i < 2; ++i) {
        const int r = (tid >> 4) + 32 * i, kk = k0 + r - 512, g = kk >> 7, cc = kk & 127;
        const float* pwr = pw + ((size_t)(g * 128 + cc)) * 128;
        const float* psr = ps + g * 128;
        const float* wr_ = wout + (size_t)(512 + g * 128) * 1024 + n0 + c4;
        f32x4 a = {0.f, 0.f, 0.f, 0.f};
        for (int d = 0; d < 128; ++d) { const float s = pwr[d] * psr[d]; const f32x4 w4 = *(const f32x4*)(wr_ + (size_t)d * 1024); a += w4 * s; }
        lds[r * 65 + c4 + 0] = a[0]; lds[r * 65 + c4 + 1] = a[1]; lds[r * 65 + c4 + 2] = a[2]; lds[r * 65 + c4 + 3] = a[3];
    }
    __syncthreads();
    tr_store(dst, 1024, k0, n0, lds, tid);
    __syncthreads();
}
__device__ void convert_layer(const Params& p, int l, unsigned char* shm, int first_block, int nblocks) {
    float* lds = (float*)shm;
    const int tid = otid(), e = l >> 1, odd = l & 1;
    unsigned char* wb = p.ws + (size_t)(l % 3) * SZ_WSET;
    bf16_t* win = (bf16_t*)(wb + OFF_WIN); bf16_t* wout = (bf16_t*)(wb + OFF_WOUT); bf16_t* wup = (bf16_t*)(wb + OFF_WUP); bf16_t* wdn = (bf16_t*)(wb + OFF_WDN);
    const int nin = odd ? 5120 : 4096;
    const int T_IN = 16 * (nin / 64), T_OUT = 256, T_UP = 16 * 88, T_DN = 44 * 16;
    const int total = T_IN + T_OUT + T_UP + T_DN;
    for (int it = obid() - first_block; it < total; it += nblocks) {
        int r = it;
        if (r < T_IN) {
            const int nb = r >> 4, kb = r & 15, n0 = nb * 64;
            int sc0 = n0;
            if (odd) { if (n0 >= 3584) sc0 = n0 - 512; else if (n0 >= 3072) sc0 = n0 + 1536; }
            const float* src = odd ? p.owin + (size_t)e * 1024 * 5120 : p.ewin + (size_t)e * 1024 * 4096;
            tr_tile(src, nin, kb * 64, sc0, win, 1024, n0, lds, tid); continue;
        }
        r -= T_IN;
        if (r < T_OUT) {
            const int nb = r >> 4, kb = r & 15;
            const float* src = odd ? p.owout + (size_t)e * 1024 * 1024 : p.ewout + (size_t)e * 1024 * 1024;
            if (odd && kb >= 8) fold_tile(p.poolw + (size_t)e * 4 * 128 * 128, p.pools + (size_t)e * 512, src, kb * 64, nb * 64, wout, lds, tid);
            else tr_tile(src, 1024, kb * 64, nb * 64, wout, 1024, nb * 64, lds, tid);
            continue;
        }
        r -= T_OUT;
        if (r < T_UP) { const int nb = r >> 4, kb = r & 15, n0 = nb * 64, tile = n0 >> 8, within = n0 & 255;
            const int sc0 = within < 128 ? 128 * tile + within : DFF + 128 * tile + within - 128;
            tr_tile(p.wup + (size_t)l * 1024 * 5632, 5632, kb * 64, sc0, wup, 1024, n0, lds, tid); continue; }
        r -= T_UP;
        { const int nb = r / 44, kb = r % 44; tr_tile(p.wdn + (size_t)l * 2816 * 1024, 1024, kb * 64, nb * 64, wdn, 2816, nb * 64, lds, tid); }
    }
}

__device__ void prep_mod(const Params& p, unsigned char* shm) {
    float* cact = (float*)shm;
    float* red = (float*)(shm + 32768);
    float* mod = (float*)(p.ws + OFF_MOD);
    const int tid = otid(), w = tid >> 6, lane = tid & 63;
    if (obid() == gridDim.x - 1) {
        float* lbp = (float*)(p.ws + OFF_LB);
        const float a = p.lblog[tid], b = p.lblog[512 + tid], mx = fmaxf(a, b), ea = __expf(a - mx), eb = __expf(b - mx);
        lbp[tid] = 0.f; lbp[512 + tid] = eb / (ea + eb);
    }
    for (int i = tid; i < 8192; i += 512) cact[i] = siluf_(p.c[i]);
    __syncthreads();
    for (int item = obid(); item < 4 * 96; item += gridDim.x) {
        const int l = item / 96, n0 = (item % 96) * 64;
        float a[8];
#pragma unroll
        for (int b = 0; b < 8; ++b) a[b] = 0.f;
        const float* wp = p.ada_w + ((size_t)l * 1024 + w * 128) * 6144 + n0 + lane;
#pragma unroll 2
        for (int k = 0; k < 128; k += 4) {
            float wv[4];
#pragma unroll
            for (int j = 0; j < 4; ++j) wv[j] = wp[(size_t)(k + j) * 6144];
#pragma unroll
            for (int b = 0; b < 8; ++b) {
                const f32x4 c4 = *(const f32x4*)(cact + b * 1024 + w * 128 + k);
                a[b] += c4[0] * wv[0] + c4[1] * wv[1] + c4[2] * wv[2] + c4[3] * wv[3];
            }
        }
#pragma unroll
        for (int b = 0; b < 8; ++b) red[(w * 8 + b) * 64 + lane] = a[b];
        __syncthreads();
        {
            const int b = tid >> 6;
            float s = p.ada_b[l * 6144 + n0 + lane];
#pragma unroll
            for (int ww = 0; ww < 8; ++ww) s += red[(ww * 8 + b) * 64 + lane];
            mod[((size_t)(l * 8 + b)) * 6144 + n0 + lane] = s;
        }
        __syncthreads();
    }
}

__device__ void norm_rows(const float* xin, const float* g, const float* modl, int sh_off, int sc_off, bf16_t* hb) {
    const int w = otid() >> 6, lane = otid() & 63;
    for (int row = obid() * 8 + w; row < MTOK; row += gridDim.x * 8) {
        const int b = row >> 12;
        const float* xr = xin + (size_t)row * DM;
        f32x4 v[4]; float ss = 0.f;
#pragma unroll
        for (int i = 0; i < 2; ++i) { v[2 * i] = *(const f32x4*)(xr + 512 * i + 8 * lane); v[2 * i + 1] = *(const f32x4*)(xr + 512 * i + 8 * lane + 4); }
#pragma unroll
        for (int i = 0; i < 4; ++i) ss += v[i][0] * v[i][0] + v[i][1] * v[i][1] + v[i][2] * v[i][2] + v[i][3] * v[i][3];
        const float rstd = rsqrtf(wave_sum64(ss) * (1.0f / DM) + RMS_EPS);
        const float* mb = modl + (size_t)b * 6144;
#pragma unroll
        for (int i = 0; i < 2; ++i) {
            const int c = 512 * i + 8 * lane;
            float o[8];
#pragma unroll
            for (int h2 = 0; h2 < 2; ++h2) {
                const f32x4 gv = *(const f32x4*)(g + c + 4 * h2), sc = *(const f32x4*)(mb + sc_off + c + 4 * h2), sh = *(const f32x4*)(mb + sh_off + c + 4 * h2);
#pragma unroll
                for (int j = 0; j < 4; ++j) o[4 * h2 + j] = v[2 * i + h2][j] * rstd * gv[j] * (1.0f + sc[j]) + sh[j];
            }
            *(u32x4*)(hb + (size_t)row * DM + c) = pack8(o);
        }
    }
}
__device__ void final_norm(float* x, const float* g) {
    const int w = otid() >> 6, lane = otid() & 63;
    for (int row = obid() * 8 + w; row < MTOK; row += gridDim.x * 8) {
        float* xr = x + (size_t)row * DM;
        f32x4 v[4]; float ss = 0.f;
#pragma unroll
        for (int i = 0; i < 4; ++i) { v[i] = *(const f32x4*)(xr + 256 * i + 4 * lane); ss += v[i][0] * v[i][0] + v[i][1] * v[i][1] + v[i][2] * v[i][2] + v[i][3] * v[i][3]; }
        const float rstd = rsqrtf(wave_sum64(ss) * (1.0f / DM) + RMS_EPS);
#pragma unroll
        for (int i = 0; i < 4; ++i) { const f32x4 gv = *(const f32x4*)(g + 256 * i + 4 * lane); *(f32x4*)(xr + 256 * i + 4 * lane) = v[i] * rstd * gv; }
    }
}

struct AttnState { f32x4 o[4]; float m, l; };
template <int NP>
__device__ __forceinline__ void attn_stepN(AttnState& st, const float (&s)[8 * NP], const bf16x8 (&vf)[NP][4]) {
    float mx = s[0];
#pragma unroll
    for (int i = 1; i < 8 * NP; ++i) mx = fmaxf(mx, s[i]);
    mx = fmaxf(mx, shx(mx, 16)); mx = fmaxf(mx, shx(mx, 32));
    const float mn = fmaxf(fmaxf(st.m, mx), -1e20f), alpha = __builtin_amdgcn_exp2f(st.m - mn);
    float ps = 0.f; bf16x8 pf[NP];
#pragma unroll
    for (int np = 0; np < NP; ++np) {
        float pv[8];
#pragma unroll
        for (int i = 0; i < 8; ++i) { pv[i] = __builtin_amdgcn_exp2f(s[8 * np + i] - mn); ps += pv[i]; }
        pf[np] = mk8u(pk2(pv[0], pv[1]), pk2(pv[2], pv[3]), pk2(pv[4], pv[5]), pk2(pv[6], pv[7]));
    }
    st.l = st.l * alpha + ps; st.m = mn;
#pragma unroll
    for (int dt = 0; dt < 4; ++dt) {
        st.o[dt] *= alpha;
#pragma unroll
        for (int np = 0; np < NP; ++np) st.o[dt] = mfma16(vf[np][dt], pf[np], st.o[dt]);
    }
}
__device__ __forceinline__ void attn_finish(AttnState& st, bf16_t* dst  ) {
    float l = st.l; l += shx(l, 16); l += shx(l, 32);
    const float inv = 1.0f / l;
#pragma unroll
    for (int dt = 0; dt < 4; ++dt) { u32x2 o; o.x = pk2(st.o[dt][0] * inv, st.o[dt][1] * inv); o.y = pk2(st.o[dt][2] * inv, st.o[dt][3] * inv); gst<u32x2>(dst + 16 * dt, o); }
}

__device__ void na_task(const Params& p, int e, int tk, int  ) {
    const int lane = otid() & 63, fr = lane & 15, fq = lane >> 4;
    const int seg = tk & 3, r = (tk >> 2) & 63, hh = (tk >> 8) & 7, b = tk >> 11, bh = b * 8 + hh;
    const bf16_t* qn = (const bf16_t*)(p.ws + OFF_ZB + ZE_QN) + (size_t)bh * 4096 * 64;
    const bf16_t* kn = (const bf16_t*)(p.ws + OFF_ZB + ZE_KN) + (size_t)bh * 4096 * 64;
    const bf16_t* vn = (const bf16_t*)(p.ws + OFF_ZB + ZE_VN) + (size_t)bh * 64 * 4096;
    const float* rpb = p.rpb + (size_t)(e * 8 + hh) * 15 * 31;
    const int c0 = 16 * seg, cw = seg == 0 ? 0 : (seg == 1 ? 8 : (seg == 2 ? 24 : 32));
    const int rs = min(max(r - 4, 0), 56);
    const int c = c0 + fr, cs = min(max(c - 8, 0), 48);
    const int dcol = cw + 4 * fq - c + 15, wlo = cs - c + 15;
    const bf16_t* qrow = qn + (size_t)(r * 64 + c) * 64 + 8 * fq;
    const bf16x8 q0 = gld<bf16x8>(qrow), q1 = gld<bf16x8>(qrow + 32);
    AttnState st;
#pragma unroll
    for (int dt = 0; dt < 4; ++dt) st.o[dt] = (f32x4){0.f, 0.f, 0.f, 0.f};
    st.m = NEG_BIG; st.l = 0.f;
#pragma unroll 1
    for (int i0 = 0; i0 < 8; i0 += 4) {
        bf16x8 kf[4][4], vf[4][4];
#pragma unroll
        for (int ii = 0; ii < 4; ++ii) {
            const int tk0 = (rs + i0 + ii) * 64 + cw;
            const bf16_t* k0p = kn + (size_t)(tk0 + fr) * 64 + 8 * fq;
            kf[ii][0] = gld<bf16x8>(k0p); kf[ii][1] = gld<bf16x8>(k0p + 32); kf[ii][2] = gld<bf16x8>(k0p + 16 * 64); kf[ii][3] = gld<bf16x8>(k0p + 16 * 64 + 32);
#pragma unroll
            for (int dt = 0; dt < 4; ++dt) { const bf16_t* vp = vn + (size_t)((tk0 >> 2) + fq) * 256 + (16 * dt + fr) * 4; vf[ii][dt] = mk8(gld<u32x2>(vp), gld<u32x2>(vp + 4 * 256)); }
        }
        float s[32];
#pragma unroll
        for (int ii = 0; ii < 4; ++ii) {
            const int krow = rs + i0 + ii;
            f32x4 s0 = {0.f, 0.f, 0.f, 0.f}, s1 = {0.f, 0.f, 0.f, 0.f};
            s0 = mfma16(kf[ii][0], q0, s0); s0 = mfma16(kf[ii][1], q1, s0);
            s1 = mfma16(kf[ii][2], q0, s1); s1 = mfma16(kf[ii][3], q1, s1);
            const float* rb = rpb + (krow - r + 7) * 31;
#pragma unroll
            for (int j = 0; j < 4; ++j) {
                const int d0 = dcol + j, d1 = d0 + 16;
                const float b0 = gld<float>(rb + min(max(d0, 0), 30)), b1 = gld<float>(rb + min(max(d1, 0), 30));
                s[8 * ii + j] = ((unsigned)(d0 - wlo) <= 15u) ? fmaf(b0, LOG2E, s0[j]) : NEG_BIG;
                s[8 * ii + 4 + j] = ((unsigned)(d1 - wlo) <= 15u) ? fmaf(b1, LOG2E, s1[j]) : NEG_BIG;
            }
        }
        attn_stepN<4>(st, s, vf);
    }
    bf16_t* hb = (bf16_t*)(p.ws + OFF_HB);
    attn_finish(st, hb + (size_t)(b * 4096 + r * 64 + c) * DM + 512 + hh * 64 + 4 * fq);
}

constexpr int DKS = 72, DVS = 392, DIL_VS_OFF = 384 * DKS * 2;
struct DilRegs { u32x4 k[6]; u32x4 v[6]; };
__device__ __forceinline__ void dil_stage_load(DilRegs& R, const bf16_t* kc_g, const bf16_t* vc_g, int tid, int nkeys, int L_, int cb0, int cbs, int ustart) {
#pragma unroll
    for (int i = 0; i < 6; ++i) {
        const int c = tid + 512 * i;
        { const int row = c >> 3, part = c & 7, s = row >= nkeys ? 1 : 0, k = row - s * nkeys, uc = min(max(ustart + k, 0), L_ - 1);
          R.k[i] = gld<u32x4>(kc_g + (size_t)(cb0 + s * cbs + uc) * 64 + part * 8); }
        { const int g = c >> 5, dvp = c & 31, col = 4 * g, s = col >= nkeys ? 1 : 0, k = col - s * nkeys, uc = min(max(ustart + k, 0), L_ - 4);
          R.v[i] = gld<u32x4>(vc_g + ((size_t)((cb0 + s * cbs + uc) >> 2) * 64 + 2 * dvp) * 4); }
    }
}
__device__ __forceinline__ void dil_stage_store(const DilRegs& R, unsigned char* shm, int tid) {
    bf16_t* KS = (bf16_t*)shm; bf16_t* VS = (bf16_t*)(shm + DIL_VS_OFF);
#pragma unroll
    for (int i = 0; i < 6; ++i) {
        const int c = tid + 512 * i;
        { const int row = c >> 3, part = c & 7; *(u32x4*)(KS + row * DKS + part * 8) = R.k[i]; }
        { const int g = c >> 5, dvp = c & 31; *(u32x2*)(VS + (2 * dvp) * DVS + 4 * g) = (u32x2){R.v[i].x, R.v[i].y}; *(u32x2*)(VS + (2 * dvp + 1) * DVS + 4 * g) = (u32x2){R.v[i].z, R.v[i].w}; }
    }
}
__device__ __forceinline__ void dil_lds_group(AttnState& st, const unsigned char* shm, int rowbase, int npair, int ustart, int uq, int L_, float slope_d, const bf16_t* qrow, int fr, int fq) {
    const bf16_t* KS = (const bf16_t*)shm; const bf16_t* VS = (const bf16_t*)(shm + DIL_VS_OFF);
    const bf16x8 q0 = gld<bf16x8>(qrow), q1 = gld<bf16x8>(qrow + 32);
    const float dbase = (float)(ustart + 4 * fq - uq), dlo = (float)max(-64, -uq), dhi = (float)min(64, L_ - 1 - uq);
#pragma unroll 1
    for (int pi0 = 0; pi0 < npair; pi0 += 2) {
        bf16x8 kf[2][4], vf[2][4];
#pragma unroll
        for (int ii = 0; ii < 2; ++ii) {
            const int kl0 = rowbase + 32 * (pi0 + ii);
            const bf16_t* kap = KS + (kl0 + fr) * DKS + 8 * fq;
            kf[ii][0] = *(const bf16x8*)kap; kf[ii][1] = *(const bf16x8*)(kap + 32); kf[ii][2] = *(const bf16x8*)(kap + 16 * DKS); kf[ii][3] = *(const bf16x8*)(kap + 16 * DKS + 32);
#pragma unroll
            for (int dt = 0; dt < 4; ++dt) { const bf16_t* vp = VS + (16 * dt + fr) * DVS + kl0 + 4 * fq; vf[ii][dt] = mk8(*(const u32x2*)vp, *(const u32x2*)(vp + 16)); }
        }
        float s[16];
#pragma unroll
        for (int ii = 0; ii < 2; ++ii) {
            f32x4 s0 = {0.f, 0.f, 0.f, 0.f}, s1 = {0.f, 0.f, 0.f, 0.f};
            s0 = mfma16(kf[ii][0], q0, s0); s0 = mfma16(kf[ii][1], q1, s0);
            s1 = mfma16(kf[ii][2], q0, s1); s1 = mfma16(kf[ii][3], q1, s1);
#pragma unroll
            for (int j = 0; j < 4; ++j) {
                const float da = dbase + (float)(32 * (pi0 + ii) + j), db = da + 16.f;
                s[8 * ii + j] = (da >= dlo && da <= dhi) ? fmaf(-slope_d, fabsf(da), s0[j]) : NEG_BIG;
                s[8 * ii + 4 + j] = (db >= dlo && db <= dhi) ? fmaf(-slope_d, fabsf(db), s1[j]) : NEG_BIG;
            }
        }
        attn_stepN<2>(st, s, vf);
    }
}
__device__ __forceinline__ void dil_lds_group_ab(AttnState& sa, AttnState& sb, const unsigned char* shm, int npair, int ustart, int uqa, int uqb, int L_, float slope_d,
                                                 const bf16_t* qrow_a, const bf16_t* qrow_b, int fr, int fq) {
    const bf16_t* KS = (const bf16_t*)shm; const bf16_t* VS = (const bf16_t*)(shm + DIL_VS_OFF);
    const bf16x8 qa0 = gld<bf16x8>(qrow_a), qa1 = gld<bf16x8>(qrow_a + 32), qb0 = gld<bf16x8>(qrow_b), qb1 = gld<bf16x8>(qrow_b + 32);
    const float dba = (float)(ustart + 4 * fq - uqa), dloa = (float)max(-64, -uqa), dhia = (float)min(64, L_ - 1 - uqa);
    const float dbb = (float)(ustart + 4 * fq - uqb), dlob = (float)max(-64, -uqb), dhib = (float)min(64, L_ - 1 - uqb);
#pragma unroll 1
    for (int pi0 = 0; pi0 < npair; pi0 += 2) {
        bf16x8 kf[2][4], vf[2][4];
#pragma unroll
        for (int ii = 0; ii < 2; ++ii) {
            const int kl0 = 32 * (pi0 + ii);
            const bf16_t* kap = KS + (kl0 + fr) * DKS + 8 * fq;
            kf[ii][0] = *(const bf16x8*)kap; kf[ii][1] = *(const bf16x8*)(kap + 32); kf[ii][2] = *(const bf16x8*)(kap + 16 * DKS); kf[ii][3] = *(const bf16x8*)(kap + 16 * DKS + 32);
#pragma unroll
            for (int dt = 0; dt < 4; ++dt) { const bf16_t* vp = VS + (16 * dt + fr) * DVS + kl0 + 4 * fq; vf[ii][dt] = mk8(*(const u32x2*)vp, *(const u32x2*)(vp + 16)); }
        }
        float s_a[16], s_b[16];
#pragma unroll
        for (int ii = 0; ii < 2; ++ii) {
            f32x4 a0 = {0.f, 0.f, 0.f, 0.f}, a1 = {0.f, 0.f, 0.f, 0.f}, b0 = {0.f, 0.f, 0.f, 0.f}, b1 = {0.f, 0.f, 0.f, 0.f};
            a0 = mfma16(kf[ii][0], qa0, a0); b0 = mfma16(kf[ii][0], qb0, b0); a1 = mfma16(kf[ii][2], qa0, a1); b1 = mfma16(kf[ii][2], qb0, b1);
            a0 = mfma16(kf[ii][1], qa1, a0); b0 = mfma16(kf[ii][1], qb1, b0); a1 = mfma16(kf[ii][3], qa1, a1); b1 = mfma16(kf[ii][3], qb1, b1);
#pragma unroll
            for (int j = 0; j < 4; ++j) {
                const float off = (float)(32 * (pi0 + ii) + j);
                const float da = dba + off, da2 = da + 16.f, db = dbb + off, db2 = db + 16.f;
                s_a[8 * ii + j] = (da >= dloa && da <= dhia) ? fmaf(-slope_d, fabsf(da), a0[j]) : NEG_BIG;
                s_a[8 * ii + 4 + j] = (da2 >= dloa && da2 <= dhia) ? fmaf(-slope_d, fabsf(da2), a1[j]) : NEG_BIG;
                s_b[8 * ii + j] = (db >= dlob && db <= dhib) ? fmaf(-slope_d, fabsf(db), b0[j]) : NEG_BIG;
                s_b[8 * ii + 4 + j] = (db2 >= dlob && db2 <= dhib) ? fmaf(-slope_d, fabsf(db2), b1[j]) : NEG_BIG;
            }
        }
        attn_stepN<2>(sa, s_a, vf);
        attn_stepN<2>(sb, s_b, vf);
    }
}
template <int NP>
__device__ __forceinline__ void dil_g2_step(AttnState& sa, AttnState& sb, const bf16_t* kc2, const bf16_t* vc2, int cba, int cbb, int uqa, int uqb, int ubeg, float sl2,
                                            bf16x8 qa0, bf16x8 qa1, bf16x8 qb0, bf16x8 qb1, int fr, int fq) {
    bf16x8 kf[2][NP][4], vf[2][NP][4];
#pragma unroll
    for (int x = 0; x < 2; ++x) {
        const int cb = x ? cbb : cba;
#pragma unroll
        for (int ii = 0; ii < NP; ++ii) {
            const int u0 = ubeg + 32 * ii;
            const int ka = min(max(u0 + fr, 0), 255), kb = min(max(u0 + 16 + fr, 0), 255);
            const int ug0 = min(max(u0 + 4 * fq, 0), 252), ug1 = min(max(u0 + 16 + 4 * fq, 0), 252);
            const bf16_t* kap = kc2 + (size_t)(cb + ka) * 64 + 8 * fq; const bf16_t* kbp = kc2 + (size_t)(cb + kb) * 64 + 8 * fq;
            kf[x][ii][0] = gld<bf16x8>(kap); kf[x][ii][1] = gld<bf16x8>(kap + 32); kf[x][ii][2] = gld<bf16x8>(kbp); kf[x][ii][3] = gld<bf16x8>(kbp + 32);
#pragma unroll
            for (int dt = 0; dt < 4; ++dt) { const bf16_t* vp = vc2 + (16 * dt + fr) * 4; vf[x][ii][dt] = mk8(gld<u32x2>(vp + (size_t)((cb + ug0) >> 2) * 256), gld<u32x2>(vp + (size_t)((cb + ug1) >> 2) * 256)); }
        }
    }
#pragma unroll
    for (int x = 0; x < 2; ++x) {
        const int uq = x ? uqb : uqa;
        float s[8 * NP];
        const float dbase = (float)(ubeg + 4 * fq - uq), dlo = (float)max(-64, -uq), dhi = (float)min(64, 255 - uq);
#pragma unroll
        for (int ii = 0; ii < NP; ++ii) {
            f32x4 s0 = {0.f, 0.f, 0.f, 0.f}, s1 = {0.f, 0.f, 0.f, 0.f};
            s0 = mfma16(kf[x][ii][0], x ? qb0 : qa0, s0); s0 = mfma16(kf[x][ii][1], x ? qb1 : qa1, s0);
            s1 = mfma16(kf[x][ii][2], x ? qb0 : qa0, s1); s1 = mfma16(kf[x][ii][3], x ? qb1 : qa1, s1);
#pragma unroll
            for (int j = 0; j < 4; ++j) {
                const float da = dbase + (float)(32 * ii + j), db = da + 16.f;
                s[8 * ii + j] = (da >= dlo && da <= dhi) ? fmaf(-sl2, fabsf(da), s0[j]) : NEG_BIG;
                s[8 * ii + 4 + j] = (db >= dlo && db <= dhi) ? fmaf(-sl2, fabsf(db), s1[j]) : NEG_BIG;
            }
        }
        attn_stepN<NP>(x ? sb : sa, s, vf[x]);
    }
}
__device__ __forceinline__ void dil_g2(AttnState& sa, AttnState& sb, const bf16_t* kc2, const bf16_t* vc2, const bf16_t* qc2, int cba, int cbb, int uqa, int uqb, int ustart, float sl2, int fr, int fq) {
    const bf16_t* qra = qc2 + (size_t)(cba + uqa) * 64 + 8 * fq; const bf16_t* qrb = qc2 + (size_t)(cbb + uqb) * 64 + 8 * fq;
    const bf16x8 qa0 = gld<bf16x8>(qra), qa1 = gld<bf16x8>(qra + 32), qb0 = gld<bf16x8>(qrb), qb1 = gld<bf16x8>(qrb + 32);
    dil_g2_step<2>(sa, sb, kc2, vc2, cba, cbb, uqa, uqb, ustart, sl2, qa0, qa1, qb0, qb1, fr, fq);
    dil_g2_step<2>(sa, sb, kc2, vc2, cba, cbb, uqa, uqb, ustart + 64, sl2, qa0, qa1, qb0, qb1, fr, fq);
    dil_g2_step<1>(sa, sb, kc2, vc2, cba, cbb, uqa, uqb, ustart + 128, sl2, qa0, qa1, qb0, qb1, fr, fq);
}
__device__ __forceinline__ float dil_slope(int gi, int hh) { return exp2f(-8.0f * (float)(gi * 8 + hh + 1) / 24.0f) * (float)(1 << (2 * gi)) * LOG2E; }
__device__ __forceinline__ void dil_stage(unsigned char* shm, const bf16_t* kc_g, const bf16_t* vc_g, int  , int nkeys, int L_, int cb0, int cbs, int ustart) {
    DilRegs R;
    const int tid = otid();
    __syncthreads();
    dil_stage_load(R, kc_g, vc_g, tid, nkeys, L_, cb0, cbs, ustart);
    dil_stage_store(R, shm, tid);
    __syncthreads();
}
__device__ void dil_block(const Params& p, unsigned char* shm) {
    const bf16_t* QC = (const bf16_t*)(p.ws + OFF_ZB + ZO_QC); const bf16_t* KC = (const bf16_t*)(p.ws + OFF_ZB + ZO_KC); const bf16_t* VC = (const bf16_t*)(p.ws + OFF_ZB + ZO_VC);
    bf16_t* hb = (bf16_t*)(p.ws + OFF_HB);
    const int G = gridDim.x;
    for (int task = obid(); task < 1024; task += G) {
        const int tid = otid(), lane = tid & 63, w = __builtin_amdgcn_readfirstlane(tid >> 6), fr = lane & 15, fq = lane >> 4;
        const int rho_a = 4 * (w >> 1) + (w & 1), rho_b = rho_a + 2, slot = w & 1;
        const int T0 = (task & 15) * 256, hh = (task >> 4) & 7, b = task >> 7;
        const size_t g0 = (size_t)((b * 3 + 0) * 8 + hh), g1 = g0 + 8, g2 = g0 + 16;
        const int tqa = T0 + rho_a + 16 * fr, tqb = T0 + rho_b + 16 * fr;
        AttnState sa, sb;
#pragma unroll
        for (int dt = 0; dt < 4; ++dt) { sa.o[dt] = (f32x4){0.f, 0.f, 0.f, 0.f}; sb.o[dt] = (f32x4){0.f, 0.f, 0.f, 0.f}; }
        sa.m = NEG_BIG; sa.l = 0.f; sb.m = NEG_BIG; sb.l = 0.f;
        dil_stage(shm, KC + g0 * 4096 * 64, VC + g0 * 64 * 4096, tid, 384, 4096, 0, 0, T0 - 64);
        { const float sl = dil_slope(0, hh);
          dil_lds_group_ab(sa, sb, shm, 12, T0 - 64, tqa, tqb, 4096, sl, QC + (g0 * 4096 + tqa) * 64 + 8 * fq, QC + (g0 * 4096 + tqb) * 64 + 8 * fq, fr, fq); }
        dil_stage(shm, KC + g1 * 4096 * 64, VC + g1 * 64 * 4096, tid, 192, 1024, 0, 1024, (T0 >> 2) - 64);
        const float sl1 = dil_slope(1, hh);
        { const int uq = tqa >> 2, cb = (rho_a & 3) * 1024;
          dil_lds_group(sa, shm, slot * 192, 6, (T0 >> 2) - 64, uq, 1024, sl1, QC + (g1 * 4096 + cb + uq) * 64 + 8 * fq, fr, fq); }
        dil_stage(shm, KC + g1 * 4096 * 64, VC + g1 * 64 * 4096, tid, 192, 1024, 2048, 1024, (T0 >> 2) - 64);
        { const int uq = tqb >> 2, cb = (rho_b & 3) * 1024;
          dil_lds_group(sb, shm, slot * 192, 6, (T0 >> 2) - 64, uq, 1024, sl1, QC + (g1 * 4096 + cb + uq) * 64 + 8 * fq, fr, fq); }
        {
            const float sl2 = dil_slope(2, hh);
            const bf16_t* kc2 = KC + g2 * 4096 * 64; const bf16_t* vc2 = VC + g2 * 64 * 4096; const bf16_t* qc2 = QC + g2 * 4096 * 64;
            dil_g2(sa, sb, kc2, vc2, qc2, rho_a * 256, rho_b * 256, tqa >> 4, tqb >> 4, (T0 >> 4) - 64, sl2, fr, fq);
        }
        attn_finish(sa, hb + (size_t)(b * 4096 + tqa) * DM + hh * 64 + 4 * fq);
        attn_finish(sb, hb + (size_t)(b * 4096 + tqb) * DM + hh * 64 + 4 * fq);
    }
    __syncthreads();
}

__device__ void pool_pass(const Params& p, int first_block, int nblocks) {
    const bf16_t* pu = (const bf16_t*)(p.ws + OFF_ZB + ZO_PU);
    bf16_t* hb = (bf16_t*)(p.ws + OFF_HB);
    for (int idx = (obid() - first_block) * 512 + otid(); idx < (MTOK / 16) * 64; idx += nblocks * 512) {
        const int c8 = (idx & 63) * 8, tok0 = (idx >> 6) * 16, gi = c8 >> 7, hw = 1 << gi, t0 = tok0 & 4095, b0 = tok0 - t0;
        const bf16_t* col = pu + (size_t)b0 * 512 + c8;
        float a[8];
#pragma unroll
        for (int i = 0; i < 8; ++i) a[i] = 0.f;
        for (int tt = max(t0 - hw, 0); tt < min(t0 + hw, 4096); ++tt) {
            float v[8]; unpack8(*(const u32x4*)(col + (size_t)tt * 512), v);
#pragma unroll
            for (int i = 0; i < 8; ++i) a[i] += v[i];
        }
#pragma unroll 4
        for (int k = 0; k < 16; ++k) {
            const int t = t0 + k, lo = max(t - hw, 0), hi = min(t + hw, 4096);
            float uv[8]; unpack8(*(const u32x4*)(col + (size_t)t * 512), uv);
            const float inv = 1.0f / (float)(hi - lo);
            float o[8];
#pragma unroll
            for (int i = 0; i < 8; ++i) o[i] = a[i] * inv - uv[i];
            *(u32x4*)(hb + (size_t)(b0 + t) * DM + 512 + c8) = pack8(o);
            if (t + hw < 4096) { float v[8]; unpack8(*(const u32x4*)(col + (size_t)(t + hw) * 512), v);
#pragma unroll
                for (int i = 0; i < 8; ++i) a[i] += v[i]; }
            if (t - hw >= 0) { float v[8]; unpack8(*(const u32x4*)(col + (size_t)(t - hw) * 512), v);
#pragma unroll
                for (int i = 0; i < 8; ++i) a[i] -= v[i]; }
        }
    }
}

__device__ void ffn_fix(const Params& p, int l) {
    bf16_t* U = (bf16_t*)(p.ws + OFF_ZB + ZF_U); const float* HG = (const float*)(p.ws + OFF_ZB + ZF_HG); const float* HV = (const float*)(p.ws + OFF_ZB + ZF_HV);
    const float* cw = p.convw + (size_t)l * 3 * DFF; const float* cb = p.convb + (size_t)l * DFF;
    for (int idx = obid() * 512 + otid(); idx < 352 * 1024; idx += gridDim.x * 512) {
        const int sb = idx / 352, f8 = (idx - sb * 352) * 8, s = sb >> 1, last = sb & 1;
        const int row = 64 * s + (last ? 63 : 0), t = row & 4095;
        const float* gc = HG + ((size_t)s * 4 + (last ? 1 : 2)) * DFF + f8;
        const float* gu = last ? HG + ((size_t)s * 4 + 0) * DFF + f8 : HG + ((size_t)(s - 1) * 4 + 1) * DFF + f8;
        const float* gd = last ? HG + ((size_t)(s + 1) * 4 + 2) * DFF + f8 : HG + ((size_t)s * 4 + 3) * DFF + f8;
        const float* vv = HV + ((size_t)s * 2 + (last ? 0 : 1)) * DFF + f8;
        const bool has_up = last || t > 0, has_dn = !last || t < 4095;
        float o[8];
#pragma unroll
        for (int h = 0; h < 2; ++h) {
            const f32x4 z4 = {0.f, 0.f, 0.f, 0.f};
            const f32x4 c4 = *(const f32x4*)(gc + 4 * h), u4 = has_up ? *(const f32x4*)(gu + 4 * h) : z4, d4 = has_dn ? *(const f32x4*)(gd + 4 * h) : z4, v4 = *(const f32x4*)(vv + 4 * h);
            const f32x4 w0 = *(const f32x4*)(cw + f8 + 4 * h), w1 = *(const f32x4*)(cw + DFF + f8 + 4 * h), w2 = *(const f32x4*)(cw + 2 * DFF + f8 + 4 * h), bb = *(const f32x4*)(cb + f8 + 4 * h);
#pragma unroll
            for (int j = 0; j < 4; ++j) o[4 * h + j] = siluf_(bb[j] + u4[j] * w0[j] + c4[j] * w1[j] + d4[j] * w2[j]) * v4[j];
        }
        *(u32x4*)(U + (size_t)row * DFF + f8) = pack8(o);
    }
}

__device__ void hgrn_combine(const Params& p, int e) {
    const bf16_t* of = (const bf16_t*)(p.ws + OFF_ZB + ZE_OF); const bf16_t* ob = (const bf16_t*)(p.ws + OFF_ZB + ZE_OB);
    const bf16_t* za = (const bf16_t*)(p.ws + OFF_ZB + ZE_ZA);
    bf16_t* hb = (bf16_t*)(p.ws + OFF_HB);
    const int w = otid() >> 6, lane = otid() & 63;
    const float* hg = p.hng + e * 128 + ((8 * lane) & 127);
    for (int tok = obid() * 8 + w; tok < MTOK; tok += gridDim.x * 8) {
        float a[8], bb[8], gs[8];
        unpack8(*(const u32x4*)(of + (size_t)tok * 512 + 8 * lane), a); unpack8(*(const u32x4*)(ob + (size_t)tok * 512 + 8 * lane), bb);
        unpack8(*(const u32x4*)(za + (size_t)tok * ZAW + 2048 + 8 * lane), gs);
        float ss = 0.f;
#pragma unroll
        for (int i = 0; i < 8; ++i) { a[i] += bb[i]; ss += a[i] * a[i]; }
        ss += shx(ss, 1); ss += shx(ss, 2); ss += shx(ss, 4); ss += shx(ss, 8);
        const float rstd = rsqrtf(ss * (1.0f / 128.0f) + RMS_EPS);
#pragma unroll
        for (int i = 0; i < 8; ++i) a[i] = a[i] * rstd * hg[i] * gs[i];
        *(u32x4*)(hb + (size_t)tok * DM + 8 * lane) = pack8(a);
    }
}

__device__ void hgrn_chain(const Params& p, int chain, unsigned char* shm) {
    const int tid = otid(), w = __builtin_amdgcn_readfirstlane(tid >> 6), lane = tid & 63, fr = lane & 15, fq = lane >> 4;
    const int b = chain >> 3, hh = (chain >> 1) & 3, dir = chain & 1;
    bf16_t* QP = (bf16_t*)(shm); bf16_t* QT = (bf16_t*)(shm + 8704); bf16_t* KT = (bf16_t*)(shm + 17408);
    bf16_t* KC = (bf16_t*)(shm + 26112); bf16_t* VC = (bf16_t*)(shm + 36352); bf16_t* ATT = (bf16_t*)(shm + 46592);
    float* GT = (float*)(shm + 49664);
    bf16_t* const KC1 = (bf16_t*)(shm + 53760); bf16_t* const VC1 = (bf16_t*)(shm + 64000); float* const DD0 = (float*)(shm + 49152); float* const DD1 = (float*)(shm + 74240);
    bf16_t* const KC0 = KC; bf16_t* const VC0 = VC;
    const bf16_t* za = (const bf16_t*)(p.ws + OFF_ZB + ZE_ZA) + (size_t)b * 4096 * ZAW;
    bf16_t* od = (bf16_t*)(p.ws + OFF_ZB + (dir ? ZE_OB : ZE_OF)) + (size_t)b * 4096 * 512 + hh * 128;
    const int qcol = hh * 128 + 2 * lane, lcol = 512 * (1 + dir) + hh * 128 + 2 * lane, vcol = 1536 + hh * 128 + 2 * lane;
    const int Vs = 16 * w;
    for (int i = tid; i < 32 * 40 / 2; i += 512) ((unsigned*)ATT)[i] = 0u;
    f32x4 S[8];
#pragma unroll
    for (int kt = 0; kt < 8; ++kt) S[kt] = (f32x4){0.f, 0.f, 0.f, 0.f};
    unsigned rq[4], rl[4], rv[4];
#pragma unroll
    for (int j = 0; j < 4; ++j) {
        const int s = 4 * w + j, t = dir ? 4095 - s : s;
        const bf16_t* row = za + (size_t)t * ZAW;
        rq[j] = gld<unsigned>(row + qcol); rl[j] = gld<unsigned>(row + lcol); rv[j] = gld<unsigned>(row + vcol);
    }
    {
        float a0 = 0.f, a1 = 0.f;
#pragma unroll
        for (int j = 0; j < 4; ++j) { a0 += bf_lo(rl[j]); a1 += bf_hi(rl[j]); }
        *(f32x2*)(GT + w * 128 + 2 * lane) = (f32x2){a0, a1};
    }
    __syncthreads();
    u32x2 po[2] = {(u32x2){0u, 0u}, (u32x2){0u, 0u}};
    for (int ci = 0; ci < 128; ++ci) {
        KC = (ci & 1) ? KC1 : KC0; VC = (ci & 1) ? VC1 : VC0; float* DD = (ci & 1) ? DD1 : DD0;
        unsigned cq[4], cl[4], cv[4];
#pragma unroll
        for (int j = 0; j < 4; ++j) { cq[j] = rq[j]; cl[j] = rl[j]; cv[j] = rv[j]; }
        if (ci + 1 < 128) {
#pragma unroll
            for (int j = 0; j < 4; ++j) {
                const int s = 32 * (ci + 1) + 4 * w + j, t = dir ? 4095 - s : s;
                const bf16_t* row = za + (size_t)t * ZAW;
                rq[j] = gld<unsigned>(row + qcol); rl[j] = gld<unsigned>(row + lcol); rv[j] = gld<unsigned>(row + vcol);
            }
        }
        if (ci > 0) {
#pragma unroll
            for (int nt = 0; nt < 2; ++nt) { const int sp = 32 * (ci - 1) + 16 * nt + fr, tp = dir ? 4095 - sp : sp; gst<u32x2>(od + (size_t)tp * 512 + Vs + 4 * fq, po[nt]); }
        }
        float lf0[4], lf1[4], p0[4], p1[4];
        float a0 = 0.f, a1 = 0.f;
#pragma unroll
        for (int j = 0; j < 4; ++j) { lf0[j] = bf_lo(cl[j]); lf1[j] = bf_hi(cl[j]); a0 += lf0[j]; a1 += lf1[j]; p0[j] = a0; p1[j] = a1; }
        float off0 = 0.f, off1 = 0.f, tot0 = 0.f, tot1 = 0.f;
#pragma unroll
        for (int ww = 0; ww < 8; ++ww) { const f32x2 g = *(const f32x2*)(GT + ww * 128 + 2 * lane); if (ww < w) { off0 += g[0]; off1 += g[1]; } tot0 += g[0]; tot1 += g[1]; }
        float kk0[4], kk1[4];
        {
            float f0[4], f1[4];
#pragma unroll
            for (int j = 0; j < 4; ++j) { f0[j] = __expf(lf0[j]); f1[j] = __expf(lf1[j]); }
            float eb0 = __expf(off0), eb1 = __expf(off1);
            const float ci0 = __expf(fminf(-tot0, 80.f)), ci1 = __expf(fminf(-tot1, 80.f));
            float ek0[4], ek1[4];
            ek0[3] = __expf(tot0 - (off0 + p0[3])); ek1[3] = __expf(tot1 - (off1 + p1[3]));
#pragma unroll
            for (int j = 2; j >= 0; --j) { ek0[j] = ek0[j + 1] * f0[j + 1]; ek1[j] = ek1[j + 1] * f1[j + 1]; }
#pragma unroll
            for (int j = 0; j < 4; ++j) {
                const int tau = 4 * w + j;
                eb0 *= f0[j]; eb1 *= f1[j];
                const float q0 = bf_lo(cq[j]), q1 = bf_hi(cq[j]);
                kk0[j] = (1.0f - f0[j]) * ek0[j]; kk1[j] = (1.0f - f1[j]) * ek1[j];
                *(unsigned*)(QP + tau * 136 + 2 * lane) = pk2(q0 * eb0, q1 * eb1);
                *(unsigned*)(KT + tau * 136 + 2 * lane) = pk2(kk0[j] * ci0, kk1[j] * ci1);
            }
        }
        { u32x2 o;
          o.x = pk2(kk0[0], kk0[1]); o.y = pk2(kk0[2], kk0[3]); *(u32x2*)(KC + (2 * lane) * 40 + 4 * w) = o;
          o.x = pk2(kk1[0], kk1[1]); o.y = pk2(kk1[2], kk1[3]); *(u32x2*)(KC + (2 * lane + 1) * 40 + 4 * w) = o;
          o.x = (cv[0] & 0xffffu) | (cv[1] << 16); o.y = (cv[2] & 0xffffu) | (cv[3] << 16); *(u32x2*)(VC + (2 * lane) * 40 + 4 * w) = o;
          o.x = (cv[0] >> 16) | (cv[1] & 0xffff0000u); o.y = (cv[2] >> 16) | (cv[3] & 0xffff0000u); *(u32x2*)(VC + (2 * lane + 1) * 40 + 4 * w) = o; }
        if (w == 0) *(f32x2*)(DD + 2 * lane) = (f32x2){__expf(tot0), __expf(tot1)};
        __syncthreads();
        if (w < 3) {
            const int st_ = (w == 2) ? 1 : 0, ct_ = (w == 0) ? 0 : 1;
            f32x4 at = {0.f, 0.f, 0.f, 0.f};
#pragma unroll
            for (int kb = 0; kb < 4; ++kb) {
                const bf16x8 A = *(const bf16x8*)(KT + (16 * st_ + fr) * 136 + 32 * kb + 8 * fq);
                const bf16x8 B = *(const bf16x8*)(QP + (16 * ct_ + fr) * 136 + 32 * kb + 8 * fq);
                at = mfma16(A, B, at);
            }
            const int c = 16 * ct_ + fr, s0 = 16 * st_ + 4 * fq;
            u32x2 o;
            o.x = pk2(s0 + 0 <= c ? at[0] : 0.f, s0 + 1 <= c ? at[1] : 0.f); o.y = pk2(s0 + 2 <= c ? at[2] : 0.f, s0 + 3 <= c ? at[3] : 0.f);
            *(u32x2*)(ATT + c * 40 + s0) = o;
        }
        f32x4 o2[2] = {(f32x4){0.f, 0.f, 0.f, 0.f}, (f32x4){0.f, 0.f, 0.f, 0.f}};
#pragma unroll
        for (int kb = 0; kb < 4; ++kb) {
            const bf16x8 A = mk8u(pk2(S[2 * kb][0], S[2 * kb][1]), pk2(S[2 * kb][2], S[2 * kb][3]), pk2(S[2 * kb + 1][0], S[2 * kb + 1][1]), pk2(S[2 * kb + 1][2], S[2 * kb + 1][3]));
#pragma unroll
            for (int nt = 0; nt < 2; ++nt) {
                const bf16_t* qp = QP + (16 * nt + fr) * 136 + 32 * kb + 4 * fq;
                const bf16x8 B = mk8(*(const u32x2*)qp, *(const u32x2*)(qp + 16));
                o2[nt] = mfma16(A, B, o2[nt]);
            }
        }
        if (ci + 1 < 128) {
            float n0 = 0.f, n1 = 0.f;
#pragma unroll
            for (int j = 0; j < 4; ++j) { n0 += bf_lo(rl[j]); n1 += bf_hi(rl[j]); }
            *(f32x2*)(GT + w * 128 + 2 * lane) = (f32x2){n0, n1};
        }
        __syncthreads();
#pragma unroll
        for (int j = 0; j < 4; ++j) asm volatile("" :: "v"(rq[j]), "v"(rv[j]));
        const bf16x8 vfrag = *(const bf16x8*)(VC + (Vs + fr) * 40 + 8 * fq);
#pragma unroll
        for (int nt = 0; nt < 2; ++nt) {
            const bf16x8 B = *(const bf16x8*)(ATT + (16 * nt + fr) * 40 + 8 * fq);
            o2[nt] = mfma16(vfrag, B, o2[nt]);
            po[nt].x = pk2(o2[nt][0], o2[nt][1]); po[nt].y = pk2(o2[nt][2], o2[nt][3]);
        }
#pragma unroll
        for (int kt = 0; kt < 8; ++kt) {
            const f32x4 d4 = *(const f32x4*)(DD + 16 * kt + 4 * fq);
            const bf16x8 A = *(const bf16x8*)(KC + (16 * kt + fr) * 40 + 8 * fq);
            S[kt] = mfma16(A, vfrag, S[kt] * d4);
        }
    }
#pragma unroll
    for (int nt = 0; nt < 2; ++nt) { const int sp = 32 * 127 + 16 * nt + fr, tp = dir ? 4095 - sp : sp; gst<u32x2>(od + (size_t)tp * 512 + Vs + 4 * fq, po[nt]); }
    __syncthreads();
}


#define XB_TMO      128
#define XB_XCNT(j)  (256  + 64 * (j))
#define XB_XSUB(j)  (1280 + 64 * (j))
#define XB_XGEN(j)  (2304 + 64 * (j))
#define XB_TOP      3328
#define XB_TOPGEN   3392
#define XCD_BAR_WORDS 3456
#define XB_SPIN_CAP (1u << 18)
__device__ __forceinline__ unsigned xb_ld(unsigned* p)              { return __hip_atomic_load(p, __ATOMIC_RELAXED, __HIP_MEMORY_SCOPE_AGENT); }
__device__ __forceinline__ unsigned xb_add(unsigned* p, unsigned v) { return __hip_atomic_fetch_add(p, v, __ATOMIC_RELAXED, __HIP_MEMORY_SCOPE_AGENT); }
__device__ __forceinline__ unsigned xb_xcc_id() { return (unsigned)__builtin_amdgcn_s_getreg((3 << 11) | 20) & 0xFu; }
#define XB_SPIN(cond, bar) do { unsigned _sp = 0; while (cond) { __builtin_amdgcn_s_sleep(1); \
    if ((++_sp & 255u) == 0u) { if (xb_ld(&(bar)[XB_TMO])) break; if (_sp > XB_SPIN_CAP) { atomicAdd(&(bar)[XB_TMO], 1u); break; } } } } while (0)
struct XcdBarrier { unsigned* bar; unsigned x; volatile LAS unsigned* st; };
__device__ __forceinline__ XcdBarrier xcd_barrier_post(unsigned* bar, volatile LAS unsigned* st) {
    XcdBarrier b; b.bar = bar; b.x = xb_xcc_id(); b.st = st;
    if (threadIdx.x == 0) (void)xb_add(&bar[XB_XCNT(b.x)], 1u);
    return b;
}
__device__ __forceinline__ void xcd_barrier_complete(unsigned* bar, unsigned x, unsigned& nloc, unsigned& nx) {
    const unsigned G = gridDim.x * gridDim.y * gridDim.z;
    unsigned sum, cnt, mine, sp = 0u;
    for (;;) {
        sum = 0u; cnt = 0u; mine = 0u;
#pragma unroll
        for (unsigned j = 0; j < 16; ++j) { const unsigned c = xb_ld(&bar[XB_XCNT(j)]); sum += c; cnt += (c > 0u) ? 1u : 0u; mine = (j == x) ? c : mine; }
        if (sum == G) break;
        __builtin_amdgcn_s_sleep(1);
        if ((++sp & 255u) == 0u) { if (xb_ld(&bar[XB_TMO])) break; if (sp > XB_SPIN_CAP) { atomicAdd(&bar[XB_TMO], 1u); break; } }
    }
    nloc = mine > 0u ? mine : 1u; nx = cnt > 0u ? cnt : 1u;
}
__device__ __forceinline__ void gbar(const XcdBarrier& b) {
    asm volatile("s_waitcnt vmcnt(0) lgkmcnt(0)" ::: "memory");
    __syncthreads();
    if (otid() == 0) {
        unsigned* bar = b.bar;
        __builtin_amdgcn_s_waitcnt(0);
        unsigned nloc = b.st[0], nx = b.st[1];
        if (nloc == 0u) { xcd_barrier_complete(bar, b.x, nloc, nx); b.st[0] = nloc; b.st[1] = nx; }
        const unsigned old = xb_add(&bar[XB_XSUB(b.x)], 1u);
        const unsigned gen = old / nloc;
        if (old + 1u == (gen + 1u) * nloc) {
            __builtin_amdgcn_fence(__ATOMIC_RELEASE, "agent");
            asm volatile("s_waitcnt vmcnt(0)" ::: "memory");
            const unsigned og = xb_add(&bar[XB_TOP], 1u);
            const unsigned tg = og / nx;
            if (og + 1u == (tg + 1u) * nx) xb_add(&bar[XB_TOPGEN], 1u);
            else XB_SPIN(xb_ld(&bar[XB_TOPGEN]) == tg, bar);
            __builtin_amdgcn_fence(__ATOMIC_ACQUIRE, "agent");
            xb_add(&bar[XB_XGEN(b.x)], 1u);
            asm volatile("s_waitcnt vmcnt(0)" ::: "memory");
        } else {
            XB_SPIN(xb_ld(&bar[XB_XGEN(b.x)]) == gen, bar);
            __builtin_amdgcn_fence(__ATOMIC_ACQUIRE, "agent");
            asm volatile("s_waitcnt vmcnt(0)" ::: "memory");
        }
    }
    __syncthreads();
}

#ifndef STOP_AFTER
#define STOP_AFTER 0
#endif
__device__ __forceinline__ void dump_bf16(float* out, const bf16_t* src, size_t n, int nsrc) {
    for (size_t i = (size_t)blockIdx.x * 512 + threadIdx.x; i < (size_t)MTOK * DM; i += (size_t)gridDim.x * 512) {
        float a = 0.f;
        for (int k = 0; k < nsrc; ++k) { const size_t j = (i + (size_t)k * MTOK * DM) % n; a += __uint_as_float(((unsigned)src[j]) << 16); }
        out[i] = a;
    }
}
#define STOP(code, src, n, nsrc) do { if (STOP_AFTER == (code)) { if ((n) > 0) dump_bf16(p.out, (src), (n), (nsrc)); return; } } while (0)

__global__ void __launch_bounds__(512, 2) fwd_megakernel(Params p0) {
    extern __shared__ __attribute__((aligned(16))) unsigned char shm[];
    cg::grid_group grid = cg::this_grid();
    LAS unsigned char* lds = (LAS unsigned char*)shm;
    const int G = gridDim.x;
    pg8::StaticOrder S;
    unsigned char* const ws = p0.ws;
    const float* mod = (const float*)(ws + OFF_MOD);
    bf16_t* hb = (bf16_t*)(ws + OFF_HB); bf16_t* zb = (bf16_t*)(ws + OFF_ZB);

    volatile LAS unsigned* xst = (volatile LAS unsigned*)(lds + 131072);
    if (threadIdx.x == 0) { xst[0] = 0u; xst[1] = 0u; }
    __syncthreads();
    const XcdBarrier xb = xcd_barrier_post((unsigned*)(p0.ws + OFF_BAR), xst);
    if (p0.ws == nullptr) grid.sync();
    if (blockIdx.x == 0 && threadIdx.x == 0) { Params* d = (Params*)(p0.ws + OFF_PRM); d->x = p0.x; d->c = p0.c; d->ada_w = p0.ada_w; d->ada_b = p0.ada_b; d->nmg = p0.nmg; d->nfg = p0.nfg; d->ewin = p0.ewin; d->ewout = p0.ewout; d->lblog = p0.lblog; d->hng = p0.hng; d->rpb = p0.rpb; d->owin = p0.owin; d->owout = p0.owout; d->poolw = p0.poolw; d->pools = p0.pools; d->wup = p0.wup; d->convw = p0.convw; d->convb = p0.convb; d->wdn = p0.wdn; d->fng = p0.fng; d->out = p0.out; d->ws = p0.ws; }
    prep_mod(p0, shm);
#ifdef DUP_PREP
    prep_mod(p0, shm); prep_mod(p0, shm);
#endif
    convert_layer(p0, 0, shm, 0, gridDim.x);
    gbar(xb);
    const Params& p = *(const Params*)(p0.ws + OFF_PRM);
    for (int l = 0; l < DEPTH; ++l) {
        const int e = l >> 1, odd = l & 1;
        const float* modl = mod + (size_t)l * NB * 6144;
        const float* xcur = (l == 0) ? p.x : p.out;
        unsigned char* const wb = ws + (size_t)(l % 3) * SZ_WSET;
        bf16_t* win = (bf16_t*)(wb + OFF_WIN); bf16_t* wout = (bf16_t*)(wb + OFF_WOUT); bf16_t* wup = (bf16_t*)(wb + OFF_WUP); bf16_t* wdn = (bf16_t*)(wb + OFF_WDN);
        if (l > 0 && G < 128) convert_layer(p, l, shm, 0, G);
        norm_rows(xcur, p.nmg + l * DM, modl, 0, DM, hb);
        gbar(xb);
        STOP(10 * l + 1, hb, (size_t)MTOK * DM, 1);
#ifdef DUP_INPROJ
        for (int rep3 = 0; rep3 < 2; ++rep3)
#endif
        if (!odd) {
            { pg8::Gemm g{hb, win, MTOK, 3584, 1024, 1024, 1024}; S.init(g.M, g.N, G, obid());
              EpiEvenIn E{zb + ZE_ZA / 2, zb + ZE_QN / 2, zb + ZE_KN / 2, (const float*)(ws + OFF_LB) + e * 512};
              pg8::gemm_phase(lds, g, S, E); }
            { pg8::Gemm g{win + (size_t)3584 * 1024, hb, 512, MTOK, 1024, 1024, 1024}; S.init(g.M, g.N, G, obid());
              EpiEvenV E{zb + ZE_VN / 2};
              pg8::gemm_phase(lds, g, S, E); }
        } else {
            { pg8::Gemm g{hb, win, MTOK, 3584, 1024, 1024, 1024}; S.init(g.M, g.N, G, obid());
              EpiOddIn E{zb + ZO_QC / 2, zb + ZO_KC / 2, zb + ZO_PU / 2};
              pg8::gemm_phase(lds, g, S, E); }
            { pg8::Gemm g{win + (size_t)3584 * 1024, hb, 1536, MTOK, 1024, 1024, 1024}; S.init(g.M, g.N, G, obid());
              EpiOddV E{zb + ZO_VC / 2};
              pg8::gemm_phase(lds, g, S, E); }
        }
        gbar(xb);
        STOP(10 * l + 2, zb, (size_t)MTOK * 5120, 5);
        const int tid_ = otid(), lane = tid_ & 63, wave = tid_ >> 6;
        if (!odd) {
#ifdef DUP_MIX_EVEN
            for (int rep = 0; rep < 2; ++rep) {
#endif
#ifndef SKIP_HGRN
            for (int ch = obid(); ch < 64; ch += G) hgrn_chain(p, ch, shm);
#endif
#ifdef DUP_HGRN
            for (int ch = obid(); ch < 64; ch += G) hgrn_chain(p, ch, shm);
#endif
            { const int nab = (G >= 128) ? G - 64 : G, na0 = (G >= 128) ? obid() - 64 : obid();
#ifndef SKIP_NA
              if (na0 >= 0) for (int tk = na0 * 8 + wave; tk < 16384; tk += nab * 8) na_task(p, e, tk, lane);
#ifdef DUP_NA
              if (na0 >= 0) for (int tk = na0 * 8 + wave; tk < 16384; tk += nab * 8) na_task(p, e, tk, lane);
              if (na0 >= 0) for (int tk = na0 * 8 + wave; tk < 16384; tk += nab * 8) na_task(p, e, tk, lane);
#endif
#endif
            }
#ifdef DUP_MIX_EVEN
            }
#endif
            if (G >= 128 && obid() >= 64) {
                convert_layer(p, l + 1, shm, 64, G - 64);
                if (l == 0) convert_layer(p, 2, shm, 64, G - 64);
            }
            gbar(xb);
            hgrn_combine(p, e);
        } else {
#ifdef DUP_MIX_ODD
            for (int rep = 0; rep < 2; ++rep) {
#endif
#ifdef DUP_DIL
            for (int rep2 = 0; rep2 < 2; ++rep2)
#endif
            dil_block(p, shm);
#ifdef DUP_POOL
            for (int rep2 = 0; rep2 < 3; ++rep2)
#endif
            pool_pass(p, 0, G);
#ifdef DUP_MIX_ODD
            }
#endif
        }
        gbar(xb);
        STOP(10 * l + 3, hb, (size_t)MTOK * DM, 1);
        { pg8::Gemm g{hb, wout, MTOK, 1024, 1024, 1024, 1024}; S.init(g.M, g.N, G, obid());
          EpiResid E{xcur, p.out, modl + 2 * DM};
          pg8::gemm_phase(lds, g, S, E); }
        gbar(xb);
        STOP(10 * l + 4, hb, (size_t)0, 0);
#ifdef DUP_NORM
        for (int rep = 0; rep < 3; ++rep)
#endif
        norm_rows(p.out, p.nfg + l * DM, modl, 3 * DM, 4 * DM, hb);
        gbar(xb);
#ifdef DUP_UP
        for (int rep4 = 0; rep4 < 2; ++rep4)
#endif
        { pg8::Gemm g{hb, wup, MTOK, 5632, 1024, 1024, 1024}; S.init(g.M, g.N, G, obid());
          EpiFfnUp E{zb + ZF_U / 2, (float*)(ws + OFF_ZB + ZF_HG), (float*)(ws + OFF_ZB + ZF_HV), p.convw + (size_t)l * 3 * DFF, p.convb + (size_t)l * DFF};
          pg8::gemm_phase(lds, g, S, E); }
        gbar(xb);
        ffn_fix(p, l);
        gbar(xb);
        { pg8::Gemm g{zb + ZF_U / 2, wdn, MTOK, 1024, 2816, 2816, 2816}; S.init(g.M, g.N, G, obid());
          EpiResid E{p.out, p.out, modl + 5 * DM};
          pg8::gemm_phase(lds, g, S, E); }
        gbar(xb);
    }
    final_norm(p.out, p.fng);
}

extern "C" void kernel_launch(void* const* d_in, const int* in_sizes, int n_in, void* d_out, int out_size, void* d_ws, size_t ws_size, hipStream_t stream) {
    constexpr size_t kLds = 131072 + 64;
    static int grid_blocks = 0;
    if (!grid_blocks) {
        int dev = 0, cus = 0, per_cu = 0;
        (void)hipGetDevice(&dev);
        (void)hipDeviceGetAttribute(&cus, hipDeviceAttributeMultiprocessorCount, dev);
        (void)hipFuncSetAttribute((const void*)fwd_megakernel, hipFuncAttributeMaxDynamicSharedMemorySize, (int)kLds);
        (void)hipOccupancyMaxActiveBlocksPerMultiprocessor(&per_cu, (const void*)fwd_megakernel, 512, kLds);
        if (per_cu < 1) per_cu = 1;
        grid_blocks = cus * per_cu;
        if (ws_size < WS_END || n_in != 20) fprintf(stderr, "kernel_launch: workspace %zu < %zu or n_in %d != 20\n", ws_size, (size_t)WS_END, n_in);
    }
    Params p{};
    const float** pp = (const float**)&p;
    for (int i = 0; i < 20; ++i) pp[i] = (const float*)d_in[i];
    p.out = (float*)d_out; p.ws = (unsigned char*)d_ws;
    (void)hipMemsetAsync((unsigned char*)d_ws + OFF_BAR, 0, 16384, stream);
    void* args[] = {&p};
    hipError_t er = hipLaunchCooperativeKernel((const void*)fwd_megakernel, dim3(grid_blocks), dim3(512), args, kLds, stream);
    if (er != hipSuccess) fprintf(stderr, "cooperative launch failed: %s (grid %d)\n", hipGetErrorString(er), grid_blocks);
}
```
